# Optimizing an MI355X kernel written in HIP

```python
import jax
import jax.numpy as jnp
from jax import lax
import numpy as np

D_MODEL = 1024
BATCH = 8
SEQ = 4096
DEPTH = 4

D_FF = 4 * D_MODEL
N_EVEN = (DEPTH + 1) // 2
N_ODD = DEPTH // 2
NORM_EPS = 1e-6
NEG_INF = -1e30

RET_HEADS = 4
RET_DK = D_MODEL // 8
RET_DV = D_MODEL // 8
RET_CHUNK = 128
ROPE_BASE = 10000.0

SWA_HEADS = 8
SWA_KV_HEADS = 2
SWA_HD = D_MODEL // 16
WINDOW = 128

GLA_HEADS = 4
GLA_DK = D_MODEL // (2 * GLA_HEADS)
GLA_DV = D_MODEL // GLA_HEADS
GLA_RANK = 16
GLA_TAU = 16.0
GLA_CHUNK = 64

EV_SPLITS = (RET_HEADS * RET_DK, RET_HEADS * RET_DK, RET_HEADS * RET_DV, RET_HEADS * RET_DV,
             SWA_HEADS * SWA_HD, SWA_KV_HEADS * SWA_HD, SWA_KV_HEADS * SWA_HD)
EV_IN = sum(EV_SPLITS)
EV_MIX = RET_HEADS * RET_DV + SWA_HEADS * SWA_HD
OD_SPLITS = (GLA_HEADS * GLA_DK, GLA_HEADS * GLA_DK, GLA_HEADS * GLA_DV, GLA_HEADS * GLA_DV, GLA_RANK)
OD_IN = sum(OD_SPLITS)
OD_MIX = GLA_HEADS * GLA_DV

kernel_name = 'hybrid_retention_swa_gla_block'


def split_cols(z, sizes):
    idx = np.cumsum(sizes)[:-1].tolist()
    return jnp.split(z, idx, axis=-1)


def rms_norm(x, g):
    xf = x.astype(jnp.float32)
    y = xf * lax.rsqrt(jnp.mean(xf * xf, axis=-1, keepdims=True) + NORM_EPS)
    return (y * g.astype(jnp.float32)).astype(x.dtype)


def head_rms_norm(o, g):
    H, d = o.shape[-2], o.shape[-1]
    y = o * lax.rsqrt(jnp.mean(o * o, axis=-1, keepdims=True) + NORM_EPS)
    return y * g.astype(jnp.float32).reshape(H, d)


def rotary(x, pos):
    half = x.shape[-1] // 2
    inv = ROPE_BASE ** (-jnp.arange(half, dtype=jnp.float32) / half)
    ang = pos.astype(jnp.float32)[:, None] * inv[None, :]
    cos = jnp.cos(ang)[None, :, None, :]
    sin = jnp.sin(ang)[None, :, None, :]
    xf = x.astype(jnp.float32)
    x1, x2 = xf[..., :half], xf[..., half:]
    return jnp.concatenate([x1 * cos - x2 * sin, x1 * sin + x2 * cos], axis=-1).astype(x.dtype)


def retention(q, k, v):
    B, T, H, dk = q.shape
    dv = v.shape[-1]
    C = RET_CHUNK
    N = T // C
    log_gamma = jnp.log1p(-(2.0 ** (-5.0 - jnp.arange(H, dtype=jnp.float32))))
    qf = q.astype(jnp.float32).reshape(B, N, C, H, dk)
    kf = k.astype(jnp.float32).reshape(B, N, C, H, dk) * (dk ** -0.5)
    vf = v.astype(jnp.float32).reshape(B, N, C, H, dv)
    idx = jnp.arange(C, dtype=jnp.float32)
    rel = idx[:, None] - idx[None, :]
    causal = rel >= 0
    decay = jnp.where(causal[None], jnp.exp(log_gamma[:, None, None] * jnp.where(causal, rel, 0.0)[None]), 0.0)
    scores = jnp.einsum('bnihd,bnjhd->bnhij', qf, kf) * decay[None, None]
    o_intra = jnp.einsum('bnhij,bnjhe->bnihe', scores, vf)
    k_dec = jnp.exp(log_gamma[None, :] * (C - 1 - idx)[:, None])
    kv = jnp.einsum('bnjhd,jh,bnjhe->nbhde', kf, k_dec, vf)
    chunk_decay = jnp.exp(log_gamma * C)[None, :, None, None]

    def step(s, kv_n):
        return chunk_decay * s + kv_n, s

    _, s_prev = lax.scan(step, jnp.zeros((B, H, dk, dv), jnp.float32), kv)
    q_dec = jnp.exp(log_gamma[None, :] * (idx + 1.0)[:, None])
    o_cross = jnp.einsum('bnihd,ih,nbhde->bnihe', qf, q_dec, s_prev)
    return (o_intra + o_cross).reshape(B, T, H, dv)


def swa_with_sinks(q, k, v, sinks):
    B, T, Hq, d = q.shape
    Hkv = k.shape[2]
    G = Hq // Hkv
    C = WINDOW
    N = T // C
    qb = q.astype(jnp.float32).reshape(B, N, C, Hkv, G, d) * (d ** -0.5)
    kb = k.astype(jnp.float32).reshape(B, N, C, Hkv, d)
    vb = v.astype(jnp.float32).reshape(B, N, C, Hkv, d)
    kk = jnp.concatenate([jnp.concatenate([jnp.zeros_like(kb[:, :1]), kb[:, :-1]], axis=1), kb], axis=2)
    vv = jnp.concatenate([jnp.concatenate([jnp.zeros_like(vb[:, :1]), vb[:, :-1]], axis=1), vb], axis=2)
    s = jnp.einsum('bnqhgd,bnkhd->bnhgqk', qb, kk)
    qpos = jnp.arange(C)[:, None] + C
    kpos = jnp.arange(2 * C)[None, :]
    diff = qpos - kpos
    allowed = (diff >= 0) & (diff < WINDOW)
    mask = allowed[None] & ((jnp.arange(N)[:, None, None] > 0) | (kpos[None] >= C))
    s = jnp.where(mask[None, :, None, None], s, NEG_INF)
    sink = sinks.astype(jnp.float32).reshape(Hkv, G)[None, None, :, :, None, None]
    m = jnp.maximum(jnp.max(s, axis=-1, keepdims=True), sink)
    p = jnp.exp(s - m)
    denom = jnp.sum(p, axis=-1, keepdims=True) + jnp.exp(sink - m)
    o = jnp.einsum('bnhgqk,bnkhd->bnqhgd', p / denom, vv)
    return o.reshape(B, T, Hq * d)


def gla(q, k, v, log_g):
    B, T, H, dk = q.shape
    dv = v.shape[-1]
    C = GLA_CHUNK
    N = T // C
    qf = q.astype(jnp.float32).reshape(B, N, C, H, dk) * (dk ** -0.5)
    kf = k.astype(jnp.float32).reshape(B, N, C, H, dk)
    vf = v.astype(jnp.float32).reshape(B, N, C, H, dv)
    b = jnp.cumsum(log_g.astype(jnp.float32).reshape(B, N, C, H, dk), axis=2)
    b_last = b[:, :, -1:]
    q_in = qf * jnp.exp(b)
    k_in = kf * jnp.exp(-b)
    causal = jnp.tril(jnp.ones((C, C), dtype=bool))
    a = jnp.where(causal, jnp.einsum('bnihd,bnjhd->bnhij', q_in, k_in), 0.0)
    o_intra = jnp.einsum('bnhij,bnjhe->bnihe', a, vf)
    kv = jnp.einsum('bnjhd,bnjhe->nbhde', kf * jnp.exp(b_last - b), vf)
    chunk_decay = jnp.moveaxis(jnp.exp(b_last[:, :, 0]), 1, 0)

    def step(s, inp):
        kv_n, dec_n = inp
        return dec_n[..., None] * s + kv_n, s

    _, s_prev = lax.scan(step, jnp.zeros((B, H, dk, dv), jnp.float32), (kv, chunk_decay))
    o_cross = jnp.einsum('bnihd,nbhde->bnihe', q_in, s_prev)
    return (o_intra + o_cross).reshape(B, T, H, dv)


def retention_swa_mixer(u, w_in, ret_norm_g, sinks, w_out, pos):
    B, T, _ = u.shape
    z = u @ w_in
    rq, rk, rv, rg, aq, ak, av = split_cols(z, EV_SPLITS)
    rq = rotary(rq.reshape(B, T, RET_HEADS, RET_DK), pos)
    rk = rotary(rk.reshape(B, T, RET_HEADS, RET_DK), pos)
    o_ret = retention(rq, rk, rv.reshape(B, T, RET_HEADS, RET_DV))
    o_ret = head_rms_norm(o_ret, ret_norm_g).reshape(B, T, RET_HEADS * RET_DV).astype(u.dtype) * jax.nn.silu(rg)
    o_att = swa_with_sinks(aq.reshape(B, T, SWA_HEADS, SWA_HD),
                           ak.reshape(B, T, SWA_KV_HEADS, SWA_HD),
                           av.reshape(B, T, SWA_KV_HEADS, SWA_HD), sinks).astype(u.dtype)
    return jnp.concatenate([o_ret, o_att], axis=-1) @ w_out


def gla_mixer(u, w_in, w_gate_up, gate_bias, norm_g, w_out):
    B, T, _ = u.shape
    z = u @ w_in
    q, k, v, r, a_low = split_cols(z, OD_SPLITS)
    log_g = jax.nn.log_sigmoid((a_low @ w_gate_up + gate_bias).astype(jnp.float32)) / GLA_TAU
    o = gla(q.reshape(B, T, GLA_HEADS, GLA_DK), k.reshape(B, T, GLA_HEADS, GLA_DK),
            v.reshape(B, T, GLA_HEADS, GLA_DV), log_g.reshape(B, T, GLA_HEADS, GLA_DK))
    o = head_rms_norm(o, norm_g).reshape(B, T, OD_MIX).astype(u.dtype) * jax.nn.silu(r)
    return o @ w_out


def sq_relu_mlp(u, w_up, w_down):
    return jnp.square(jax.nn.relu(u @ w_up)) @ w_down


def setup_inputs(seed: int = 0) -> dict:
    key = jax.random.key(seed)
    ks = jax.random.split(key, 14)
    f32 = jnp.float32

    def nrm(k, shape, fan_in):
        return jax.random.normal(k, shape, f32) * (fan_in ** -0.5)

    return {
        'x': jax.random.normal(ks[0], (BATCH, SEQ, D_MODEL), f32),
        'norm_g': 1.0 + 0.02 * jax.random.normal(ks[1], (DEPTH, 4, D_MODEL), f32),
        'w_up': nrm(ks[2], (DEPTH, D_MODEL, D_FF), D_MODEL),
        'w_down': nrm(ks[3], (DEPTH, D_FF, D_MODEL), D_FF),
        'ev_w_in': nrm(ks[4], (N_EVEN, D_MODEL, EV_IN), D_MODEL),
        'ev_ret_norm_g': 1.0 + 0.02 * jax.random.normal(ks[5], (N_EVEN, RET_HEADS * RET_DV), f32),
        'ev_sinks': 0.5 * jax.random.normal(ks[6], (N_EVEN, SWA_HEADS), f32),
        'ev_w_out': nrm(ks[7], (N_EVEN, EV_MIX, D_MODEL), EV_MIX),
        'od_w_in': nrm(ks[8], (N_ODD, D_MODEL, OD_IN), D_MODEL),
        'od_w_gate_up': nrm(ks[9], (N_ODD, GLA_RANK, GLA_HEADS * GLA_DK), GLA_RANK),
        'od_gate_bias': 0.1 * jax.random.normal(ks[10], (N_ODD, GLA_HEADS * GLA_DK), f32),
        'od_norm_g': 1.0 + 0.02 * jax.random.normal(ks[11], (N_ODD, OD_MIX), f32),
        'od_w_out': nrm(ks[12], (N_ODD, OD_MIX, D_MODEL), OD_MIX),
    }


def reference(x, norm_g, w_up, w_down, ev_w_in, ev_ret_norm_g, ev_sinks, ev_w_out,
              od_w_in, od_w_gate_up, od_gate_bias, od_norm_g, od_w_out):
    h = x
    pos = jnp.arange(x.shape[1], dtype=jnp.int32)
    for layer in range(DEPTH):
        i = layer // 2
        u = rms_norm(h, norm_g[layer, 0])
        if layer % 2 == 0:
            u = retention_swa_mixer(u, ev_w_in[i], ev_ret_norm_g[i], ev_sinks[i], ev_w_out[i], pos)
        else:
            u = gla_mixer(u, od_w_in[i], od_w_gate_up[i], od_gate_bias[i], od_norm_g[i], od_w_out[i])
        h = h + rms_norm(u, norm_g[layer, 1])
        u = sq_relu_mlp(rms_norm(h, norm_g[layer, 2]), w_up[layer], w_down[layer])
        h = h + rms_norm(u, norm_g[layer, 3])
    return h
```

```cpp
#include <hip/hip_runtime.h>
#include <cstdio>
#include <cstdint>
#include <cmath>
namespace pg8 {
#define PG8_LAS __attribute__((address_space(3)))
typedef unsigned short bf16_t;
typedef short bf16x8 __attribute__((ext_vector_type(8)));
typedef float f32x4 __attribute__((ext_vector_type(4)));
typedef unsigned u32x4 __attribute__((ext_vector_type(4)));
constexpr int BM = 256, BK = 64, HALF = 128, HTB = HALF * BK * 2  , STAGE_BYTES = 8 * HTB, NXCD = 8, WGM = 8;

__host__ __device__ __forceinline__ int lds_byte(int r, int c) { const int st = (r >> 4) * 2 + (c >> 5), rr = r & 15, cc = c & 31, ob = rr * 64 + cc * 2; return st * 1024 + (ob ^ (((ob >> 9) & 1) << 5)); }
__host__ __device__ __forceinline__ void stage_rc(int b, int& R, int& C) { const int st = b / 1024, sb = b % 1024, swz = sb ^ (((sb >> 9) & 1) << 5); R = (st >> 1) * 16 + swz / 64; C = (st & 1) * 32 + (swz % 64) / 2; }
__host__ __device__ __forceinline__ int perm32(int rho) { const int n = rho >> 4, i = rho & 15; return 8 * (i >> 2) + 4 * n + (i & 3); }

struct Unit { int pm, pn; };
struct Gemm { const bf16_t* A; const bf16_t* Bt; int M, N, K; };

struct StaticOrder {
    int nM, nN, nwg, G, c;
    __host__ __device__ void init(int M, int N, int G_, int c_) { nM = M / BM; nN = N / BM; nwg = nM * nN; G = G_; c = c_; }
    __host__ __device__ bool next(int i, Unit& u) const {
        const long L = (long)i * G + c; if (L >= nwg) return false;
        int wgid = (int)L; { const int q = nwg / NXCD, r = nwg % NXCD, xcd = wgid % NXCD, off = wgid / NXCD; wgid = (xcd < r ? xcd * (q + 1) : r * (q + 1) + (xcd - r) * q) + off; }
        const int nig = WGM * nN, gid = wgid / nig, fm = gid * WGM, gsz = (nM - fm) < WGM ? (nM - fm) : WGM;
        u.pm = fm + ((wgid % nig) % gsz); u.pn = (wgid % nig) / gsz; return true;
    }
    __device__ __forceinline__ void a_ready(const Unit&) const {}
    __device__ __forceinline__ void done(const Unit&) const {}
};

typedef __bf16 bf16x2_t __attribute__((ext_vector_type(2)));
typedef float f32x2_t __attribute__((ext_vector_type(2)));
__device__ __forceinline__ unsigned cvt_pk_bf16(float lo, float hi) { const f32x2_t v = {lo, hi}; const bf16x2_t b = __builtin_convertvector(v, bf16x2_t); return __builtin_bit_cast(unsigned, b); }
struct EpiSt {
    static constexpr bool PERM = true, AFTER_DRAIN = false;
    bf16_t* O; int ldc; int nvalid; int act; float* Of0; float* Of1;
    __device__ __forceinline__ void operator()(const f32x4 (&acc)[2][2][4][2], const Unit& u, int wr, int wc, int fr, int fq) const {
        const int row0 = u.pm * BM + wr * 64 + fr; const int col0 = u.pn * BM + wc * 32 + 8 * fq;
        if (Of0) {
            typedef _Float16 h2_t __attribute__((ext_vector_type(2))); typedef float f2_t __attribute__((ext_vector_type(2)));
            unsigned short* Oh = (unsigned short*)Of0;
#pragma unroll
            for (int ai = 0; ai < 2; ++ai)
#pragma unroll
                for (int m = 0; m < 4; ++m) { unsigned short* rowp = Oh + (size_t)(row0 + ai * HALF + m * 16) * 1024 + col0;
#pragma unroll
                    for (int bj = 0; bj < 2; ++bj) { const f32x4 v0 = acc[ai][bj][m][0], v1 = acc[ai][bj][m][1]; u32x4 w;
                        w.x = __builtin_bit_cast(unsigned, __builtin_convertvector((f2_t){v0[0], v0[1]}, h2_t)); w.y = __builtin_bit_cast(unsigned, __builtin_convertvector((f2_t){v0[2], v0[3]}, h2_t));
                        w.z = __builtin_bit_cast(unsigned, __builtin_convertvector((f2_t){v1[0], v1[1]}, h2_t)); w.w = __builtin_bit_cast(unsigned, __builtin_convertvector((f2_t){v1[2], v1[3]}, h2_t));
                        *(u32x4*)(rowp + bj * HALF) = w; } }
            return;
        }
#pragma unroll
        for (int ai = 0; ai < 2; ++ai)
#pragma unroll
            for (int m = 0; m < 4; ++m) { bf16_t* rowp = O + (size_t)(row0 + ai * HALF + m * 16) * ldc + col0;
#pragma unroll
                for (int bj = 0; bj < 2; ++bj) { f32x4 v0 = acc[ai][bj][m][0], v1 = acc[ai][bj][m][1];
                    if (act == 2) {
#pragma unroll
                        for (int e = 0; e < 4; ++e) { const float a = fmaxf(v0[e], 0.f), b = fmaxf(v1[e], 0.f); v0[e] = a * a; v1[e] = b * b; } }
                    u32x4 w; w.x = cvt_pk_bf16(v0[0], v0[1]); w.y = cvt_pk_bf16(v0[2], v0[3]); w.z = cvt_pk_bf16(v1[0], v1[1]); w.w = cvt_pk_bf16(v1[2], v1[3]);
                    if (col0 + bj * HALF + 8 <= nvalid) *(u32x4*)(rowp + bj * HALF) = w; } }
    }
};

template <class Epi, class Sched, bool ALIGN_EPI = false, bool SP2 = false>
__device__ __forceinline__ void gemm_phase(PG8_LAS unsigned char* lds, const Gemm g, const Sched& S, const Epi& E) {
    int tid = threadIdx.x; asm volatile("" : "+v"(tid));
    const int wid = __builtin_amdgcn_readfirstlane(tid >> 6), lane = tid & 63, wr = wid >> 2, wc = wid & 3, fr = lane & 15, fq = lane >> 4;
    const int K = g.K, nt = K / BK;
    unsigned voffA[2], voffB[2];
#pragma unroll
    for (int i = 0; i < 2; ++i) { int R, C; stage_rc(tid * 16 + i * 8192, R, C); const int Rb = Epi::PERM ? ((R & ~31) + perm32(R & 31)) : R;
        voffA[i] = (unsigned)(R * K + C) * 2u; voffB[i] = (unsigned)(Rb * K + C) * 2u; }
    const size_t kstep = (size_t)(BK * 2);
    const size_t hstep = (size_t)HALF * K * 2;
    const size_t tstep = 2 * hstep;
    const unsigned ldsw = (unsigned)wid * 1024u;
    const int aoff = lds_byte(wr * 64 + fr, fq * 8), boff = lds_byte(wc * 32 + fr, fq * 8);
#define PG8_SA(b, h) (((b) * 2 + (h)) * HTB)
#define PG8_SB(b, h) ((4 + (b) * 2 + (h)) * HTB)
#define PG8_STAGE(bufoff, gbase, voff) do { _Pragma("unroll") for (int _i = 0; _i < 2; ++_i) \
        __builtin_amdgcn_global_load_lds((const unsigned*)((const char*)(gbase) + (voff)[_i]), (PG8_LAS unsigned*)(lds + (bufoff) + ldsw + _i * 8192), 16, 0, 0); } while (0)
#define PG8_LDA(dst, b, h) do { _Pragma("unroll") for (int m = 0; m < 4; ++m) _Pragma("unroll") for (int k = 0; k < 2; ++k) dst[m][k] = *(const PG8_LAS bf16x8*)(lds + PG8_SA(b, h) + aoff + m * 2048 + k * 1024); } while (0)
#define PG8_LDB(dst, b, h) do { _Pragma("unroll") for (int n = 0; n < 2; ++n) _Pragma("unroll") for (int k = 0; k < 2; ++k) dst[n][k] = *(const PG8_LAS bf16x8*)(lds + PG8_SB(b, h) + boff + n * 2048 + k * 1024); } while (0)
#define PG8_MMA(ai, bj, At, Bt) do { __builtin_amdgcn_s_setprio(1); _Pragma("unroll") for (int m = 0; m < 4; ++m) _Pragma("unroll") for (int n = 0; n < 2; ++n) _Pragma("unroll") for (int k = 0; k < 2; ++k) \
        acc[ai][bj][m][n] = __builtin_amdgcn_mfma_f32_16x16x32_bf16(Bt[n][k], At[m][k], acc[ai][bj][m][n], 0, 0, 0); __builtin_amdgcn_s_setprio(0); } while (0)
#define PG8_WAIT_V(n) asm volatile("s_waitcnt vmcnt(" #n ")" ::: "memory")
#define PG8_WAIT_L(n) asm volatile("s_waitcnt lgkmcnt(" #n ")" ::: "memory")
#define PG8_BAR __builtin_amdgcn_s_barrier()
#define PG8_SCHED __builtin_amdgcn_sched_barrier(0)
    Unit cur, nxt; int ui = 0;
    if (!S.next(0, cur)) return;
    f32x4 acc[2][2][4][2];
#pragma unroll
    for (int a = 0; a < 2; ++a)
#pragma unroll
        for (int b = 0; b < 2; ++b)
#pragma unroll
            for (int m = 0; m < 4; ++m)
#pragma unroll
                for (int n = 0; n < 2; ++n) acc[a][b][m][n] = (f32x4){0.f, 0.f, 0.f, 0.f};
    bf16x8 At[4][2], B0[2][2], B1[2][2];
    const char* cA = (const char*)g.A + (size_t)cur.pm * tstep; const char* cB = (const char*)g.Bt + (size_t)cur.pn * tstep;
    S.a_ready(cur);
    if constexpr (SP2) {
        PG8_STAGE(PG8_SB(0, 0), cB, voffB); PG8_STAGE(PG8_SB(0, 1), cB + hstep, voffB); PG8_STAGE(PG8_SA(0, 0), cA, voffA); PG8_STAGE(PG8_SA(0, 1), cA + hstep, voffA);
        if (wr == 1) PG8_BAR;
        PG8_WAIT_V(2); PG8_BAR;
        PG8_STAGE(PG8_SB(1, 0), cB + kstep, voffB); PG8_STAGE(PG8_SA(1, 0), cA + kstep, voffA); PG8_STAGE(PG8_SB(1, 1), cB + hstep + kstep, voffB);
        PG8_WAIT_V(6); PG8_BAR;
    } else {
        PG8_STAGE(PG8_SB(0, 0), cB, voffB); PG8_STAGE(PG8_SA(0, 0), cA, voffA); PG8_STAGE(PG8_SB(0, 1), cB + hstep, voffB); PG8_STAGE(PG8_SA(0, 1), cA + hstep, voffA);
        if (wr == 1) PG8_BAR;
        PG8_WAIT_V(4); PG8_BAR;
        PG8_STAGE(PG8_SB(1, 0), cB + kstep, voffB); PG8_STAGE(PG8_SA(1, 0), cA + kstep, voffA); PG8_STAGE(PG8_SB(1, 1), cB + hstep + kstep, voffB);
        PG8_WAIT_V(6); PG8_BAR;
    }
    for (;;) {
        const bool has_next = S.next(ui + 1, nxt);
        const char* nA = has_next ? (const char*)g.A + (size_t)nxt.pm * tstep : cA; const char* nB = has_next ? (const char*)g.Bt + (size_t)nxt.pn * tstep : cB;
        for (int t = 0; t < nt; t += 2) {
            const bool last = (t == nt - 2);
            const char* a1 = cA + (size_t)(t + 1) * kstep;
            const char* a2 = last ? nA : cA + (size_t)(t + 2) * kstep; const char* b2 = last ? nB : cB + (size_t)(t + 2) * kstep;
            const char* a3 = a2 + kstep; const char* b3 = b2 + kstep;
            if (last && has_next) S.a_ready(nxt);
            if constexpr (SP2) {
            PG8_LDB(B0, 0, 0); PG8_LDB(B1, 0, 1); PG8_SCHED; PG8_LDA(At, 0, 0); PG8_STAGE(PG8_SA(1, 1), a1 + hstep, voffA);
            PG8_WAIT_V(8); PG8_WAIT_L(0); PG8_BAR; PG8_MMA(0, 0, At, B0); PG8_MMA(0, 1, At, B1); PG8_BAR; PG8_SCHED;
            PG8_LDA(At, 0, 1); PG8_STAGE(PG8_SB(0, 0), b2, voffB); PG8_STAGE(PG8_SB(0, 1), b2 + hstep, voffB); PG8_STAGE(PG8_SA(0, 0), a2, voffA);
            PG8_WAIT_V(8); PG8_WAIT_L(0); PG8_BAR; PG8_MMA(1, 0, At, B0); PG8_MMA(1, 1, At, B1); PG8_BAR; PG8_SCHED;
            PG8_LDB(B0, 1, 0); PG8_LDB(B1, 1, 1); PG8_SCHED; PG8_LDA(At, 1, 0); PG8_STAGE(PG8_SA(0, 1), a2 + hstep, voffA);
            PG8_WAIT_V(8); PG8_WAIT_L(0); PG8_BAR; PG8_MMA(0, 0, At, B0); PG8_MMA(0, 1, At, B1); PG8_BAR; PG8_SCHED;
            PG8_LDA(At, 1, 1); PG8_STAGE(PG8_SB(1, 0), b3, voffB); PG8_STAGE(PG8_SB(1, 1), b3 + hstep, voffB); PG8_STAGE(PG8_SA(1, 0), a3, voffA);
            PG8_WAIT_V(8); PG8_WAIT_L(0); PG8_BAR; PG8_MMA(1, 0, At, B0); PG8_MMA(1, 1, At, B1); PG8_BAR; PG8_SCHED;
            } else {
            PG8_LDB(B0, 0, 0); PG8_SCHED; PG8_LDA(At, 0, 0); PG8_STAGE(PG8_SA(1, 1), a1 + hstep, voffA);
            PG8_WAIT_L(8); PG8_BAR; PG8_WAIT_L(0); PG8_MMA(0, 0, At, B0); PG8_BAR; PG8_SCHED;
            PG8_LDB(B1, 0, 1); PG8_STAGE(PG8_SB(0, 0), b2, voffB);
            PG8_BAR; PG8_WAIT_L(0); PG8_MMA(0, 1, At, B1); PG8_BAR;
            PG8_LDA(At, 0, 1); PG8_STAGE(PG8_SA(0, 0), a2, voffA);
            PG8_BAR; PG8_WAIT_L(0); PG8_MMA(1, 0, At, B0); PG8_BAR; PG8_SCHED;
            PG8_STAGE(PG8_SB(0, 1), b2 + hstep, voffB);
            PG8_WAIT_V(6); PG8_BAR; PG8_MMA(1, 1, At, B1); PG8_BAR;
            PG8_LDB(B0, 1, 0); PG8_SCHED; PG8_LDA(At, 1, 0); PG8_STAGE(PG8_SA(0, 1), a2 + hstep, voffA);
            PG8_WAIT_L(8); PG8_BAR; PG8_WAIT_L(0); PG8_MMA(0, 0, At, B0); PG8_BAR; PG8_SCHED;
            PG8_LDB(B1, 1, 1); PG8_STAGE(PG8_SB(1, 0), b3, voffB);
            PG8_BAR; PG8_WAIT_L(0); PG8_MMA(0, 1, At, B1); PG8_BAR;
            PG8_LDA(At, 1, 1); PG8_STAGE(PG8_SA(1, 0), a3, voffA);
            PG8_BAR; PG8_WAIT_L(0); PG8_MMA(1, 0, At, B0); PG8_BAR; PG8_SCHED;
            PG8_STAGE(PG8_SB(1, 1), b3 + hstep, voffB);
            PG8_WAIT_V(6); PG8_BAR; PG8_MMA(1, 1, At, B1); PG8_BAR;
            }
        }
        if constexpr (ALIGN_EPI) { if (wr == 0) PG8_BAR; }
        if constexpr (!Epi::AFTER_DRAIN) { E(acc, cur, wr, wc, fr, fq); S.done(cur); }
        if (!has_next) break;
#pragma unroll
        for (int a = 0; a < 2; ++a)
#pragma unroll
            for (int b = 0; b < 2; ++b)
#pragma unroll
                for (int m = 0; m < 4; ++m)
#pragma unroll
                    for (int n = 0; n < 2; ++n) acc[a][b][m][n] = (f32x4){0.f, 0.f, 0.f, 0.f};
        cur = nxt; cA = nA; cB = nB; ++ui;
        if constexpr (ALIGN_EPI) { if (wr == 1) PG8_BAR; }
    }
    PG8_WAIT_V(0);
    if constexpr (!ALIGN_EPI) { if (wr == 0) PG8_BAR; }
    PG8_BAR;
    if constexpr (Epi::AFTER_DRAIN) { E.fused(acc, cur, wr, wc, fr, fq, lds, wid, lane); S.done(cur); }
#undef PG8_SA
#undef PG8_SB
#undef PG8_STAGE
#undef PG8_LDA
#undef PG8_LDB
#undef PG8_MMA
#undef PG8_WAIT_V
#undef PG8_WAIT_L
#undef PG8_BAR
#undef PG8_SCHED
}
}
#include <hip/hip_cooperative_groups.h>
namespace cg = cooperative_groups;
#define LAS __attribute__((address_space(3)))
typedef unsigned short bf16_t;
typedef short bf16x8 __attribute__((ext_vector_type(8)));
typedef float f32x4 __attribute__((ext_vector_type(4)));
typedef unsigned u32x4 __attribute__((ext_vector_type(4)));
typedef unsigned u32x2 __attribute__((ext_vector_type(2)));

constexpr int NB = 8, T = 4096, D = 1024, M = NB * T, FF = 4096, DEPTH = 4;
constexpr int EV_IN = 2816, OD_IN = 3088, OD_INP = 3328, OD_LD = 3328;
constexpr float EPS = 1e-6f;
constexpr int NTHREADS = 512, NWAVES = 8;
constexpr int LDS_BYTES = 147456;

constexpr size_t MiB = 1u << 20;
constexpr size_t WS_EVIN = 0;
constexpr size_t WS_ODIN = 11 * MiB;
constexpr size_t WS_UP = 24 * MiB;
constexpr size_t WS_DN = 56 * MiB;
constexpr size_t WS_EVOUT = 88 * MiB;
constexpr size_t WS_ODOUT = 92 * MiB;
constexpr size_t WS_ROT = 96 * MiB;
constexpr size_t WS_U = 98 * MiB;
constexpr size_t WS_MIX = 162 * MiB;
constexpr size_t WS_Z = 226 * MiB;
constexpr size_t WS_ST = 434 * MiB;
constexpr size_t WS_DEC = 498 * MiB;
constexpr size_t WS_CTL = 499 * MiB;
constexpr size_t WS_END = 500 * MiB;

struct Params {
    const float* x; const float* norm_g; const float* w_up; const float* w_down; const float* ev_w_in; const float* ev_ret_norm_g; const float* ev_sinks;
    const float* ev_w_out; const float* od_w_in; const float* od_w_gate_up; const float* od_gate_bias; const float* od_norm_g; const float* od_w_out;
    float* out; unsigned char* ws;
    int s_lo, s_hi;
};

__device__ __forceinline__ float wave_sum(float v) {
#pragma unroll
    for (int o = 1; o < 64; o <<= 1) v += __shfl_xor(v, o);
    return v;
}
__device__ __forceinline__ float lo_bf(unsigned w) { return __uint_as_float(w << 16); }
__device__ __forceinline__ float hi_bf(unsigned w) { return __uint_as_float(w & 0xffff0000u); }
__device__ __forceinline__ unsigned pk2(float lo, float hi) { return pg8::cvt_pk_bf16(lo, hi); }
__device__ __forceinline__ unsigned short f2bf(float f) { return (unsigned short)(pg8::cvt_pk_bf16(f, 0.f) & 0xffffu); }
__device__ __forceinline__ void unpack8(const u32x4 v, float (&f)[8]) {
    f[0] = lo_bf(v.x); f[1] = hi_bf(v.x); f[2] = lo_bf(v.y); f[3] = hi_bf(v.y); f[4] = lo_bf(v.z); f[5] = hi_bf(v.z); f[6] = lo_bf(v.w); f[7] = hi_bf(v.w);
}
__device__ __forceinline__ u32x4 pack8(const float (&f)[8]) { u32x4 w; w.x = pk2(f[0], f[1]); w.y = pk2(f[2], f[3]); w.z = pk2(f[4], f[5]); w.w = pk2(f[6], f[7]); return w; }
#define LDS_WAIT() asm volatile("s_waitcnt lgkmcnt(0)" ::: "memory")
#define MFMA16(b, a, c) __builtin_amdgcn_mfma_f32_16x16x32_bf16((b), (a), (c), 0, 0, 0)

__device__ __forceinline__ void transpose_item(const float* W, int K, int N, bf16_t* WT, LAS float* scr, int item, int nblk, int lane) {
    const int kb = item / nblk, nb = item % nblk, k0 = 64 * kb, n0 = 32 * nb;
    const int nn = n0 + (lane & 31); const bool ok = nn < N;
    float v[32];
    const float* wp = W + (size_t)(k0 + (lane >> 5)) * N + (ok ? nn : 0);
#pragma unroll
    for (int i = 0; i < 32; ++i) v[i] = wp[(size_t)(2 * i) * N];
#pragma unroll
    for (int i = 0; i < 32; ++i) { const int kk = 2 * i + (lane >> 5); scr[kk * 33 + (lane & 31)] = ok ? v[i] : 0.f; }
    LDS_WAIT();
    const int c = lane & 7;
#pragma unroll
    for (int j = 0; j < 4; ++j) { const int n = (lane >> 3) + 8 * j; const LAS float* s = scr + (8 * c) * 33 + n;
        u32x4 o; o.x = pk2(s[0 * 33], s[1 * 33]); o.y = pk2(s[2 * 33], s[3 * 33]); o.z = pk2(s[4 * 33], s[5 * 33]); o.w = pk2(s[6 * 33], s[7 * 33]);
        *(u32x4*)(WT + (size_t)(n0 + n) * K + k0 + 8 * c) = o; }
    LDS_WAIT();
}
__device__ __forceinline__ void mat_desc(const Params& p, int mi, const float*& W, int& K, int& N, int& NP, bf16_t*& WT) {
    unsigned char* ws = p.ws;
    if (mi < 2) { W = p.ev_w_in + (size_t)mi * 1024 * EV_IN; K = 1024; N = EV_IN; NP = EV_IN; WT = (bf16_t*)(ws + WS_EVIN) + (size_t)mi * EV_IN * 1024; }
    else if (mi < 4) { const int i = mi - 2; W = p.od_w_in + (size_t)i * 1024 * OD_IN; K = 1024; N = OD_IN; NP = OD_INP; WT = (bf16_t*)(ws + WS_ODIN) + (size_t)i * OD_INP * 1024; }
    else if (mi < 8) { const int l = mi - 4; W = p.w_up + (size_t)l * 1024 * FF; K = 1024; N = FF; NP = FF; WT = (bf16_t*)(ws + WS_UP) + (size_t)l * FF * 1024; }
    else if (mi < 12) { const int l = mi - 8; W = p.w_down + (size_t)l * FF * 1024; K = FF; N = 1024; NP = 1024; WT = (bf16_t*)(ws + WS_DN) + (size_t)l * 1024 * FF; }
    else if (mi < 14) { const int i = mi - 12; W = p.ev_w_out + (size_t)i * 1024 * 1024; K = 1024; N = 1024; NP = 1024; WT = (bf16_t*)(ws + WS_EVOUT) + (size_t)i * 1024 * 1024; }
    else { const int i = mi - 14; W = p.od_w_out + (size_t)i * 1024 * 1024; K = 1024; N = 1024; NP = 1024; WT = (bf16_t*)(ws + WS_ODOUT) + (size_t)i * 1024 * 1024; }
}

__device__ __forceinline__ void norm_phase(const float* Y, const float* Y1, const float* hin, float* hout, const float* g_post, const float* g_pre, bf16_t* U, int gw, int NGW, int lane, float* t0 = nullptr, bool t0_final = false) {
    const int bx = gw / NWAVES % 8, lw = (gw / NWAVES / 8) * NWAVES + gw % NWAVES, NLW = NGW / 8;
    for (int ml = lw; ml < T; ml += 2 * NLW) {
        int m[2]; m[0] = bx * T + ml; m[1] = m[0] + NLW;
        f32x4 h[2][4], y[2][4];
#pragma unroll
        for (int q = 0; q < 2; ++q) { const f32x4* hr = (const f32x4*)(hin + (size_t)m[q] * D) + lane;
#pragma unroll
            for (int j = 0; j < 4; ++j) h[q][j] = __builtin_nontemporal_load(&hr[64 * j]);
            if (Y) { typedef _Float16 h4_t __attribute__((ext_vector_type(4))); const h4_t* yr = (const h4_t*)((const unsigned short*)Y + (size_t)m[q] * D) + lane;
#pragma unroll
                for (int j = 0; j < 4; ++j) { const h4_t yh = __builtin_nontemporal_load(&yr[64 * j]); y[q][j] = (f32x4){(float)yh[0], (float)yh[1], (float)yh[2], (float)yh[3]}; } } }
        if (Y) {
            float s[2];
#pragma unroll
            for (int q = 0; q < 2; ++q) { s[q] = 0.f;
#pragma unroll
                for (int j = 0; j < 4; ++j) s[q] += (y[q][j][0] * y[q][j][0] + y[q][j][1] * y[q][j][1]) + (y[q][j][2] * y[q][j][2] + y[q][j][3] * y[q][j][3]); }
            s[0] = wave_sum(s[0]); s[1] = wave_sum(s[1]);
            const f32x4* gp = (const f32x4*)g_post + lane;
#pragma unroll
            for (int q = 0; q < 2; ++q) { const float r = rsqrtf(s[q] * (1.f / D) + EPS); f32x4* ho = (f32x4*)(hout + (size_t)m[q] * D) + lane;
#pragma unroll
                for (int j = 0; j < 4; ++j) { h[q][j] = h[q][j] + y[q][j] * r * gp[64 * j]; __builtin_nontemporal_store(h[q][j], &ho[64 * j]); } }
        }
        if (g_pre) {
            float s[2];
#pragma unroll
            for (int q = 0; q < 2; ++q) { s[q] = 0.f;
#pragma unroll
                for (int j = 0; j < 4; ++j) s[q] += (h[q][j][0] * h[q][j][0] + h[q][j][1] * h[q][j][1]) + (h[q][j][2] * h[q][j][2] + h[q][j][3] * h[q][j][3]); }
            s[0] = wave_sum(s[0]); s[1] = wave_sum(s[1]);
            const f32x4* gp = (const f32x4*)g_pre + lane;
#pragma unroll
            for (int q = 0; q < 2; ++q) { const float r = rsqrtf(s[q] * (1.f / D) + EPS); u32x2* uo = (u32x2*)(U + (size_t)m[q] * D) + lane;
#pragma unroll
                for (int j = 0; j < 4; ++j) { const f32x4 v = h[q][j] * r * gp[64 * j]; u32x2 w; w.x = pk2(v[0], v[1]); w.y = pk2(v[2], v[3]); uo[64 * j] = w; } }
        }
    }
    if (t0 && lw == 0) {
        constexpr int T0_H_ = 0, T0_U_ = 8192, T0_Y_ = 57344;
        f32x4* hr = (f32x4*)(t0 + T0_H_ + bx * 1024) + lane; const f32x4* yr = (const f32x4*)(t0 + T0_Y_ + bx * 1024) + lane;
        f32x4 h[4], y[4]; float s = 0.f;
#pragma unroll
        for (int j = 0; j < 4; ++j) { h[j] = hr[64 * j]; y[j] = yr[64 * j]; s += (y[j][0] * y[j][0] + y[j][1] * y[j][1]) + (y[j][2] * y[j][2] + y[j][3] * y[j][3]); }
        const float r = rsqrtf(wave_sum(s) * (1.f / D) + EPS); const f32x4* gp = (const f32x4*)g_post + lane;
#pragma unroll
        for (int j = 0; j < 4; ++j) { h[j] = h[j] + y[j] * r * gp[64 * j]; hr[64 * j] = h[j]; }
        if (t0_final) { f32x4* ho = (f32x4*)(hout + (size_t)bx * T * D) + lane;
#pragma unroll
            for (int j = 0; j < 4; ++j) ho[64 * j] = h[j]; }
        if (g_pre) { float s2 = 0.f;
#pragma unroll
            for (int j = 0; j < 4; ++j) s2 += (h[j][0] * h[j][0] + h[j][1] * h[j][1]) + (h[j][2] * h[j][2] + h[j][3] * h[j][3]);
            const float r2 = rsqrtf(wave_sum(s2) * (1.f / D) + EPS); const f32x4* gq = (const f32x4*)g_pre + lane; f32x4* ur = (f32x4*)(t0 + T0_U_ + bx * 1024) + lane;
#pragma unroll
            for (int j = 0; j < 4; ++j) ur[64 * j] = h[j] * r2 * gq[64 * j]; }
    }
}
__device__ __forceinline__ void prologue_phase(const Params& p, LAS unsigned char* lds, int tid, int wave, int lane) {
    const int G = gridDim.x, gw = blockIdx.x * NWAVES + wave, NGW = G * NWAVES;
    LAS float* scr = (LAS float*)(lds + wave * 16384);
    constexpr int NITEMS = 2 * 16 * 88 + 2 * 16 * 104 + 4 * 16 * 128 + 4 * 64 * 32 + 4 * 16 * 32;
    for (int it = gw; it < NITEMS; it += NGW) {
        int r = it, mi = 0;
        for (; mi < 16; ++mi) { const int cnt = mi < 2 ? 16 * 88 : mi < 4 ? 16 * 104 : mi < 8 ? 16 * 128 : mi < 12 ? 64 * 32 : 16 * 32; if (r < cnt) break; r -= cnt; }
        const float* W; int K, N, NP; bf16_t* WT; mat_desc(p, mi, W, K, N, NP, WT);
        transpose_item(W, K, N, WT, scr, r, NP / 32, lane);
    }
    float* cosT = (float*)(p.ws + WS_ROT); float* sinT = cosT + T * 64;
    for (int idx = blockIdx.x * NTHREADS + tid; idx < T * 64; idx += G * NTHREADS) {
        const int pos = idx >> 6, i = idx & 63;
        const float invf = (float)exp(-(double)i * (9.210340371976184 / 64.0));
        const float angf = (float)pos * invf;
        double rv = (double)angf * 0.15915494309189535; rv -= floor(rv);
        const float rf = (float)rv;
        cosT[idx] = __builtin_amdgcn_cosf(rf); sinT[idx] = __builtin_amdgcn_sinf(rf);
    }
    norm_phase(nullptr, nullptr, p.x, nullptr, nullptr, p.norm_g, (bf16_t*)(p.ws + WS_U), gw, NGW, lane);
}

constexpr int SW_KS = 72, SW_VS = 280, SW_PS = 168;
constexpr int SW_K_OFF = 0, SW_V_OFF = 272 * SW_KS * 2, SW_P_OFF = SW_V_OFF + 64 * SW_VS * 2;
static_assert(SW_P_OFF + 8 * 16 * SW_PS * 2 <= LDS_BYTES, "swa lds");
__device__ __forceinline__ void swa_unit(LAS unsigned char* lds, const bf16_t* Z, bf16_t* MIX, const float* sinks, int b, int kvh, int n, int tid, int w, int lane) {
    LAS bf16_t* Ks = (LAS bf16_t*)(lds + SW_K_OFF); LAS bf16_t* VTs = (LAS bf16_t*)(lds + SW_V_OFF); LAS bf16_t* Pw = (LAS bf16_t*)(lds + SW_P_OFF) + w * 16 * SW_PS;
    const int fr = lane & 15, fq = lane >> 4;
    const size_t rowb = (size_t)b * T;
    for (int idx = tid; idx < 272 * 8; idx += NTHREADS) { const int jj = idx >> 3, c = idx & 7; const int t = n * 128 - 128 + jj;
        u32x4 v = (u32x4){0u, 0u, 0u, 0u};
        if (jj < 256 && t >= 0) v = *(const u32x4*)(Z + (rowb + t) * EV_IN + 2560 + kvh * 64 + c * 8);
        *(LAS u32x4*)(Ks + jj * SW_KS + c * 8) = v; }
    { const int jj = tid & 255, eh = tid >> 8; const int t = n * 128 - 128 + jj;
#pragma unroll
        for (int c = 0; c < 4; ++c) { u32x4 v = (u32x4){0u, 0u, 0u, 0u};
            if (t >= 0) v = *(const u32x4*)(Z + (rowb + t) * EV_IN + 2688 + kvh * 64 + eh * 32 + c * 8);
            LAS bf16_t* dst = VTs + (eh * 32 + c * 8) * SW_VS + jj;
            dst[0 * SW_VS] = (bf16_t)(v.x & 0xffffu); dst[1 * SW_VS] = (bf16_t)(v.x >> 16); dst[2 * SW_VS] = (bf16_t)(v.y & 0xffffu); dst[3 * SW_VS] = (bf16_t)(v.y >> 16);
            dst[4 * SW_VS] = (bf16_t)(v.z & 0xffffu); dst[5 * SW_VS] = (bf16_t)(v.z >> 16); dst[6 * SW_VS] = (bf16_t)(v.w & 0xffffu); dst[7 * SW_VS] = (bf16_t)(v.w >> 16); } }
    for (int idx = tid; idx < 64 * 24; idx += NTHREADS) VTs[(idx / 24) * SW_VS + 256 + (idx % 24)] = 0;
    __syncthreads();
    const int i = 16 * w + fr; const size_t qrow = rowb + n * 128 + i;
#pragma unroll 1
    for (int g = 0; g < 4; ++g) {
        const int hq = kvh * 4 + g; const float sink = sinks[hq];
        bf16x8 aq[2];
#pragma unroll
        for (int ks = 0; ks < 2; ++ks) aq[ks] = *(const bf16x8*)(Z + qrow * EV_IN + 2048 + hq * 64 + ks * 32 + 8 * fq);
        f32x4 s[10];
#pragma unroll
        for (int nt = 0; nt < 10; ++nt) { s[nt] = (f32x4){0.f, 0.f, 0.f, 0.f};
#pragma unroll
            for (int ks = 0; ks < 2; ++ks) { const bf16x8 bk = *(const LAS bf16x8*)(Ks + (16 * (w + nt) + fr) * SW_KS + ks * 32 + 8 * fq); s[nt] = MFMA16(bk, aq[ks], s[nt]); } }
        float mx = sink;
#pragma unroll
        for (int nt = 0; nt < 10; ++nt)
#pragma unroll
            for (int c = 0; c < 4; ++c) { const int jj = 16 * (w + nt) + 4 * fq + c; const bool ok = (jj > i) && (jj <= i + 128) && (n > 0 || jj >= 128);
                const float v = ok ? s[nt][c] * 0.125f : -1e30f; s[nt][c] = v; mx = fmaxf(mx, v); }
        mx = fmaxf(mx, __shfl_xor(mx, 16)); mx = fmaxf(mx, __shfl_xor(mx, 32));
        float sum = 0.f;
#pragma unroll
        for (int nt = 0; nt < 10; ++nt) {
#pragma unroll
            for (int c = 0; c < 4; ++c) { const float pv = __expf(s[nt][c] - mx); s[nt][c] = pv; sum += pv; }
            u32x2 wv; wv.x = pk2(s[nt][0], s[nt][1]); wv.y = pk2(s[nt][2], s[nt][3]);
            *(LAS u32x2*)(Pw + fr * SW_PS + 16 * nt + 4 * fq) = wv; }
        sum += __shfl_xor(sum, 16); sum += __shfl_xor(sum, 32);
        sum += __expf(sink - mx);
        LDS_WAIT();
        f32x4 o[4];
#pragma unroll
        for (int nt = 0; nt < 4; ++nt) o[nt] = (f32x4){0.f, 0.f, 0.f, 0.f};
#pragma unroll
        for (int ks = 0; ks < 5; ++ks) { const bf16x8 ap = *(const LAS bf16x8*)(Pw + fr * SW_PS + ks * 32 + 8 * fq);
#pragma unroll
            for (int nt = 0; nt < 4; ++nt) { const bf16x8 bv = *(const LAS bf16x8*)(VTs + (16 * nt + fr) * SW_VS + 16 * w + ks * 32 + 8 * fq); o[nt] = MFMA16(bv, ap, o[nt]); } }
        LDS_WAIT();
        const float inv = 1.f / sum;
#pragma unroll
        for (int nt = 0; nt < 4; ++nt) { u32x2 wv; wv.x = pk2(o[nt][0] * inv, o[nt][1] * inv); wv.y = pk2(o[nt][2] * inv, o[nt][3] * inv);
            *(u32x2*)(MIX + qrow * D + 512 + hq * 64 + 16 * nt + 4 * fq) = wv; }
    }
    __syncthreads();
}

constexpr int LA_S = 136;
constexpr int LA_R0 = 0, LA_R1 = 128 * LA_S * 2, LA_X = 2 * 128 * LA_S * 2;
static_assert(LA_X + 256 * LA_S * 2 <= LDS_BYTES && 128 * 129 * 4 <= 256 * LA_S * 2, "la lds");

template <bool GLA> struct LaC { static constexpr int DV = GLA ? 256 : 128, LD = GLA ? OD_LD : EV_IN, GOFF = GLA ? 2048 : 1536; };

__device__ __forceinline__ void gla_compute_b(LAS unsigned char* lds, int xoff, const bf16_t* Z, size_t row0, int h, const float* Wg, const float* bias, int tid) {
    LAS float* Xb = (LAS float*)(lds + xoff); LAS float* al = (LAS float*)(lds + LA_R0); LAS float* tot = al + 128 * 16;
#ifdef DBG_NOB
    { const int d = tid & 127, jq = tid >> 7; for (int jj = 0; jj < 32; ++jj) { const int j = jq * 32 + jj; Xb[j * 129 + d] = -0.05f * (float)(j + 1) * (1.f + (float)d * (1.f / 128.f)); } __syncthreads(); return; }
#endif
    if (tid < 256) { const int j = tid >> 1, c = tid & 1; const u32x4 v = *(const u32x4*)(Z + (row0 + j) * OD_LD + 3072 + c * 8); float f[8]; unpack8(v, f);
        *(LAS f32x4*)(al + j * 16 + c * 8) = (f32x4){f[0], f[1], f[2], f[3]}; *(LAS f32x4*)(al + j * 16 + c * 8 + 4) = (f32x4){f[4], f[5], f[6], f[7]}; }
    __syncthreads();
    const int d = tid & 127, jq = tid >> 7;
    float wg[16];
#pragma unroll
    for (int r = 0; r < 16; ++r) wg[r] = Wg[r * 512 + h * 128 + d];
    const float bs = bias[h * 128 + d];
    float s = 0.f;
#pragma unroll 4
    for (int jj = 0; jj < 32; ++jj) { const int j = jq * 32 + jj; float x = bs;
#pragma unroll
        for (int r4 = 0; r4 < 4; ++r4) { const f32x4 a = *(const LAS f32x4*)(al + j * 16 + r4 * 4); x += a[0] * wg[r4 * 4 + 0] + a[1] * wg[r4 * 4 + 1] + a[2] * wg[r4 * 4 + 2] + a[3] * wg[r4 * 4 + 3]; }
        const float lg = (fminf(x, 0.f) - __logf(1.f + __expf(-fabsf(x)))) * (1.f / 16.f);
        s += lg; Xb[j * 129 + d] = s; }
    tot[jq * 128 + d] = s;
    __syncthreads();
    float off = 0.f;
#pragma unroll
    for (int q = 0; q < 3; ++q) if (q < jq) off += tot[q * 128 + d];
    if (jq > 0) {
#pragma unroll 4
        for (int jj = 0; jj < 32; ++jj) Xb[(jq * 32 + jj) * 129 + d] += off; }
    __syncthreads();
}

template <bool ROT> __device__ __forceinline__ void load_rot8(const bf16_t* src, const float* cosr, const float* sinr, float (&r1)[8], float (&r2)[8]) {
    const u32x4 a = *(const u32x4*)src, b = *(const u32x4*)(src + 64); unpack8(a, r1); unpack8(b, r2);
    if (ROT) { const f32x4 c0 = *(const f32x4*)cosr, c1 = *(const f32x4*)(cosr + 4), s0 = *(const f32x4*)sinr, s1 = *(const f32x4*)(sinr + 4);
#pragma unroll
        for (int e = 0; e < 8; ++e) { const float cs = e < 4 ? c0[e & 3] : c1[e & 3], sn = e < 4 ? s0[e & 3] : s1[e & 3]; const float t1 = r1[e] * cs - r2[e] * sn, t2 = r1[e] * sn + r2[e] * cs; r1[e] = t1; r2[e] = t2; } }
}

template <bool GLA, int NR> __device__ __forceinline__ void la_stage_vt(LAS unsigned char* lds, int xoff, const bf16_t* Z, size_t row0, int h, int e0, int tid) {
    constexpr int DV = LaC<GLA>::DV, LD = LaC<GLA>::LD;
    LAS bf16_t* VT = (LAS bf16_t*)(lds + xoff);
    const int j = tid & 127, eq = tid >> 7; const bf16_t* vrow = Z + (row0 + j) * LD + 1024 + h * DV + e0 + eq * (NR / 4);
#pragma unroll
    for (int c = 0; c < NR / 32; ++c) { const u32x4 v = *(const u32x4*)(vrow + c * 8); LAS bf16_t* dst = VT + (eq * (NR / 4) + c * 8) * LA_S + j;
        dst[0 * LA_S] = (bf16_t)(v.x & 0xffffu); dst[1 * LA_S] = (bf16_t)(v.x >> 16); dst[2 * LA_S] = (bf16_t)(v.y & 0xffffu); dst[3 * LA_S] = (bf16_t)(v.y >> 16);
        dst[4 * LA_S] = (bf16_t)(v.z & 0xffffu); dst[5 * LA_S] = (bf16_t)(v.z >> 16); dst[6 * LA_S] = (bf16_t)(v.w & 0xffffu); dst[7 * LA_S] = (bf16_t)(v.w >> 16); }
}

template <bool GLA> __device__ __forceinline__ void la1_unit(LAS unsigned char* lds, const Params& p, int li, int u, int half, int tid, int w, int lane) {
    constexpr int DV = LaC<GLA>::DV, LD = LaC<GLA>::LD, MT = DV / 128;
    const bf16_t* Z = (const bf16_t*)(p.ws + WS_Z); bf16_t* ST = (bf16_t*)(p.ws + WS_ST); float* DEC = (float*)(p.ws + WS_DEC);
    const float* cosT = (const float*)(p.ws + WS_ROT); const float* sinT = cosT + T * 64;
    const int b = u >> 7, h = (u >> 5) & 3, n = u & 31; const size_t row0 = (size_t)b * T + n * 128;
    const int fr = lane & 15, fq = lane >> 4;
    constexpr int LA1X = LA_R1;
    LAS bf16_t* KdT = (LAS bf16_t*)(lds + LA_R0); LAS float* Xb = (LAS float*)(lds + LA1X); LAS bf16_t* VT = (LAS bf16_t*)(lds + LA1X);
    if (GLA) gla_compute_b(lds, LA1X, Z, row0, h, p.od_w_gate_up + (size_t)li * 16 * 512, p.od_gate_bias + li * 512, tid);
    const float lgam = GLA ? 0.f : log1pf(-exp2f(-5.f - (float)h));
    {   const int j = tid >> 2, pq = tid & 3, pos = n * 128 + j, js = j ^ (16 * pq); const bf16_t* krow = Z + (row0 + j) * LD + 512 + h * 128;
#pragma unroll
        for (int c = 0; c < 2; ++c) { const int i0 = pq * 8 + c * 32; float r1[8], r2[8];
#ifdef DBG_NOROT
            load_rot8<false>(krow + i0, cosT + pos * 64 + i0, sinT + pos * 64 + i0, r1, r2);
#else
            load_rot8<!GLA>(krow + i0, cosT + pos * 64 + i0, sinT + pos * 64 + i0, r1, r2);
#endif
#pragma unroll
            for (int e = 0; e < 8; ++e) { const int d1 = i0 + e, d2 = d1 + 64; float f1, f2;
                if (GLA) { f1 = __expf(Xb[127 * 129 + d1] - Xb[j * 129 + d1]); f2 = __expf(Xb[127 * 129 + d2] - Xb[j * 129 + d2]); } else { f1 = f2 = __expf(lgam * (float)(127 - j)); }
                KdT[d1 * LA_S + js] = f2bf(r1[e] * f1); KdT[d2 * LA_S + js] = f2bf(r2[e] * f2); } }
#ifndef DBG_NODEC
        if (GLA && w < 2 && half == 0) DEC[(size_t)u * 128 + (tid & 127)] = __expf(Xb[127 * 129 + (tid & 127)]);
#endif
    }
    __syncthreads();
    la_stage_vt<GLA, DV>(lds, LA1X, Z, row0, h, 0, tid);
    __syncthreads();
    f32x4 acc[MT][8];
#pragma unroll
    for (int mt = 0; mt < MT; ++mt)
#pragma unroll
        for (int nt = 0; nt < 8; ++nt) acc[mt][nt] = (f32x4){0.f, 0.f, 0.f, 0.f};
#pragma unroll
    for (int ks = 0; ks < 4; ++ks) { bf16x8 a[MT];
#pragma unroll
        for (int mt = 0; mt < MT; ++mt) a[mt] = *(const LAS bf16x8*)(VT + (w * 16 * MT + 16 * mt + fr) * LA_S + ks * 32 + 8 * fq);
#pragma unroll
        for (int nt = 0; nt < 8; ++nt) { bf16x8 bb = *(const LAS bf16x8*)(KdT + (16 * nt + fr) * LA_S + ((ks * 32 + 8 * fq) ^ (16 * ((2 * nt + (fr >> 3)) & 3))));
#ifdef DBG_ONEK
            bb = (bf16x8){0x3f80, 0x3f80, 0x3f80, 0x3f80, 0x3f80, 0x3f80, 0x3f80, 0x3f80};
#endif
#ifdef DBG_ONEV
            a[0] = (bf16x8){0x3f80, 0x3f80, 0x3f80, 0x3f80, 0x3f80, 0x3f80, 0x3f80, 0x3f80};
#endif
#pragma unroll
            for (int mt = 0; mt < MT; ++mt) acc[mt][nt] = MFMA16(bb, a[mt], acc[mt][nt]); } }
    bf16_t* stu = ST + (size_t)u * DV * 128 + (size_t)half * 128 * 128;
#pragma unroll
    for (int mt = 0; mt < MT; ++mt)
#pragma unroll
        for (int nt = 0; nt < 8; ++nt) { u32x2 wv; wv.x = pk2(acc[mt][nt][0], acc[mt][nt][1]); wv.y = pk2(acc[mt][nt][2], acc[mt][nt][3]);
#ifdef DBG_CONSTST
            wv.x = pk2((float)(u & 63), (float)nt); wv.y = pk2((float)fr, (float)fq);
#endif
            *(u32x2*)(stu + (size_t)(w * 16 * MT + 16 * mt + fr) * 128 + 16 * nt + 4 * fq) = wv; }
    __syncthreads();
}

template <bool GLA> __device__ __forceinline__ void la2_phase(const Params& p, int tid, int bx, int rk, int NL) {
    constexpr int DV = LaC<GLA>::DV;
    bf16_t* ST = (bf16_t*)(p.ws + WS_ST); const float* DEC = (const float*)(p.ws + WS_DEC);
    const int totl = 4 * DV * 16;
    for (int itl = rk * NTHREADS + tid; itl < totl; itl += NL * NTHREADS) { const int it = bx * totl + itl;
        const int dg = it & 15, e = (it >> 4) % DV, bh = it / (16 * DV);
        const float cdec = GLA ? 0.f : __expf(128.f * log1pf(-exp2f(-5.f - (float)(bh & 3))));
        float S[8];
#pragma unroll
        for (int k = 0; k < 8; ++k) S[k] = 0.f;
#pragma unroll 4
        for (int n = 0; n < 32; ++n) { const size_t u = (size_t)bh * 32 + n; u32x4* ptr = (u32x4*)(ST + (u * DV + e) * 128 + dg * 8);
            const u32x4 kvw = *ptr; float kv[8]; unpack8(kvw, kv);
            float dc[8];
            if (GLA) { const f32x4 d0 = *(const f32x4*)(DEC + u * 128 + dg * 8), d1 = *(const f32x4*)(DEC + u * 128 + dg * 8 + 4);
                dc[0] = d0[0]; dc[1] = d0[1]; dc[2] = d0[2]; dc[3] = d0[3]; dc[4] = d1[0]; dc[5] = d1[1]; dc[6] = d1[2]; dc[7] = d1[3]; }
            else {
#pragma unroll
                for (int k = 0; k < 8; ++k) dc[k] = cdec; }
            *ptr = pack8(S);
#pragma unroll
            for (int k = 0; k < 8; ++k) S[k] = dc[k] * S[k] + kv[k]; }
    }
}

template <bool GLA> __device__ __forceinline__ void la3_unit(LAS unsigned char* lds, const Params& p, int li, int u, int tid, int w, int lane) {
    constexpr int DV = LaC<GLA>::DV, LD = LaC<GLA>::LD, GOFF = LaC<GLA>::GOFF, NT = DV / 16;
    const bf16_t* Z = (const bf16_t*)(p.ws + WS_Z); const bf16_t* ST = (const bf16_t*)(p.ws + WS_ST); bf16_t* MIX = (bf16_t*)(p.ws + WS_MIX);
    const float* cosT = (const float*)(p.ws + WS_ROT); const float* sinT = cosT + T * 64;
    const float* ng = GLA ? p.od_norm_g + li * 1024 : p.ev_ret_norm_g + li * 512;
    const int b = u >> 7, h = (u >> 5) & 3, n = u & 31; const size_t row0 = (size_t)b * T + n * 128;
    const int fr = lane & 15, fq = lane >> 4;
    LAS bf16_t* Qin = (LAS bf16_t*)(lds + LA_R0); LAS bf16_t* Kin = (LAS bf16_t*)(lds + LA_R1); LAS float* Xb = (LAS float*)(lds + LA_X); LAS bf16_t* Xs = (LAS bf16_t*)(lds + LA_X);
    if (GLA) gla_compute_b(lds, LA_X, Z, row0, h, p.od_w_gate_up + (size_t)li * 16 * 512, p.od_gate_bias + li * 512, tid);
    const float lgam = GLA ? 0.f : log1pf(-exp2f(-5.f - (float)h));
    const float scale = 0.08838834764831845f;
    {   const int j = tid >> 2, pq = tid & 3, pos = n * 128 + j; const bf16_t* qrow = Z + (row0 + j) * LD + h * 128; const bf16_t* krow = qrow + 512;
#pragma unroll
        for (int c = 0; c < 2; ++c) { const int i0 = pq * 8 + c * 32; float q1[8], q2[8], k1[8], k2[8];
            load_rot8<!GLA>(qrow + i0, cosT + pos * 64 + i0, sinT + pos * 64 + i0, q1, q2);
            load_rot8<!GLA>(krow + i0, cosT + pos * 64 + i0, sinT + pos * 64 + i0, k1, k2);
#pragma unroll
            for (int e = 0; e < 8; ++e) { float b1, b2;
                if (GLA) { b1 = Xb[j * 129 + i0 + e]; b2 = Xb[j * 129 + 64 + i0 + e]; } else { b1 = b2 = lgam * (float)(j + 1); }
                q1[e] *= scale * __expf(b1); q2[e] *= scale * __expf(b2); k1[e] *= __expf(-b1); k2[e] *= __expf(-b2); }
            *(LAS u32x4*)(Qin + j * LA_S + i0) = pack8(q1); *(LAS u32x4*)(Qin + j * LA_S + 64 + i0) = pack8(q2);
            *(LAS u32x4*)(Kin + j * LA_S + i0) = pack8(k1); *(LAS u32x4*)(Kin + j * LA_S + 64 + i0) = pack8(k2); }
    }
    __syncthreads();
    {   const bf16_t* stu = ST + (size_t)u * DV * 128;
        for (int idx = tid; idx < DV * 16; idx += NTHREADS) { const int e = idx >> 4, c = idx & 15; *(LAS u32x4*)(Xs + e * LA_S + c * 8) = *(const u32x4*)(stu + (size_t)e * 128 + c * 8); } }
    __syncthreads();
    f32x4 acco[NT], accA[8];
#pragma unroll
    for (int nt = 0; nt < NT; ++nt) acco[nt] = (f32x4){0.f, 0.f, 0.f, 0.f};
#pragma unroll
    for (int nt = 0; nt < 8; ++nt) accA[nt] = (f32x4){0.f, 0.f, 0.f, 0.f};
#pragma unroll
    for (int ks = 0; ks < 4; ++ks) { const bf16x8 a = *(const LAS bf16x8*)(Qin + (16 * w + fr) * LA_S + ks * 32 + 8 * fq);
#pragma unroll
        for (int nt = 0; nt < NT; ++nt) { const bf16x8 bb = *(const LAS bf16x8*)(Xs + (16 * nt + fr) * LA_S + ks * 32 + 8 * fq); acco[nt] = MFMA16(bb, a, acco[nt]); }
#pragma unroll
        for (int nt = 0; nt < 8; ++nt) if (nt <= w) { const bf16x8 bb = *(const LAS bf16x8*)(Kin + (16 * nt + fr) * LA_S + ks * 32 + 8 * fq); accA[nt] = MFMA16(bb, a, accA[nt]); } }
    {   const int i = 16 * w + fr;
#pragma unroll
        for (int nt = 0; nt < 8; ++nt)
#pragma unroll
            for (int c = 0; c < 4; ++c) { const int j = 16 * nt + 4 * fq + c; if (j > i) accA[nt][c] = 0.f; } }
    __syncthreads();
#pragma unroll
    for (int nt = 0; nt < 8; ++nt) { u32x2 wv; wv.x = pk2(accA[nt][0], accA[nt][1]); wv.y = pk2(accA[nt][2], accA[nt][3]); *(LAS u32x2*)(Qin + (16 * w + fr) * LA_S + 16 * nt + 4 * fq) = wv; }
    la_stage_vt<GLA, LaC<GLA>::DV>(lds, LA_X, Z, row0, h, 0, tid);
    __syncthreads();
#pragma unroll
    for (int ks = 0; ks < 4; ++ks) if (2 * ks <= w) { const bf16x8 a = *(const LAS bf16x8*)(Qin + (16 * w + fr) * LA_S + ks * 32 + 8 * fq);
#pragma unroll
        for (int nt = 0; nt < NT; ++nt) { const bf16x8 bb = *(const LAS bf16x8*)(Xs + (16 * nt + fr) * LA_S + ks * 32 + 8 * fq); acco[nt] = MFMA16(bb, a, acco[nt]); } }
    float ss = 0.f;
#pragma unroll
    for (int nt = 0; nt < NT; ++nt) ss += (acco[nt][0] * acco[nt][0] + acco[nt][1] * acco[nt][1]) + (acco[nt][2] * acco[nt][2] + acco[nt][3] * acco[nt][3]);
    ss += __shfl_xor(ss, 16); ss += __shfl_xor(ss, 32);
    const float r = rsqrtf(ss * (1.f / DV) + EPS);
    const size_t orow = row0 + 16 * w + fr;
#pragma unroll
    for (int nt = 0; nt < NT; ++nt) { const int e = 16 * nt + 4 * fq; const f32x4 g4 = *(const f32x4*)(ng + h * DV + e);
        const u32x2 gw2 = *(const u32x2*)(Z + orow * LD + GOFF + h * DV + e);
        const float g0 = lo_bf(gw2.x), g1 = hi_bf(gw2.x), g2 = lo_bf(gw2.y), g3 = hi_bf(gw2.y);
        const float v0 = acco[nt][0] * r * g4[0] * (g0 / (1.f + __expf(-g0))), v1 = acco[nt][1] * r * g4[1] * (g1 / (1.f + __expf(-g1)));
        const float v2 = acco[nt][2] * r * g4[2] * (g2 / (1.f + __expf(-g2))), v3 = acco[nt][3] * r * g4[3] * (g3 / (1.f + __expf(-g3)));
        u32x2 wv; wv.x = pk2(v0, v1); wv.y = pk2(v2, v3);
        *(u32x2*)(MIX + orow * D + h * DV + e) = wv; }
    __syncthreads();
}

__device__ __forceinline__ float block_sum(float v, LAS float* red, int tid) {
    v = wave_sum(v); __syncthreads(); if ((tid & 63) == 0) red[tid >> 6] = v; __syncthreads();
    float t = 0.f;
#pragma unroll
    for (int i = 0; i < NWAVES; ++i) t += red[i];
    return t;
}
template <bool ADD> __device__ __forceinline__ void t0_rmsnorm_(const LAS float* in, const float* g, LAS float* dst, LAS float* red, int tid) {
    const float a = in[tid], b = in[tid + 512]; const float r = rsqrtf(block_sum(a * a + b * b, red, tid) * (1.f / D) + EPS);
    if (ADD) { dst[tid] += a * r * g[tid]; dst[tid + 512] += b * r * g[tid + 512]; } else { dst[tid] = a * r * g[tid]; dst[tid + 512] = b * r * g[tid + 512]; }
    __syncthreads();
}
__device__ __forceinline__ void t0_gemv(const float* W, int K, int N, const LAS float* in, LAS float* outv, int act, int tid) {
    for (int n = tid; n < N; n += NTHREADS) { float acc[8];
#pragma unroll
        for (int i = 0; i < 8; ++i) acc[i] = 0.f;
        for (int k = 0; k < K; k += 8) {
#pragma unroll
            for (int i = 0; i < 8; ++i) acc[i] += in[k + i] * W[(size_t)(k + i) * N + n]; }
        float a = ((acc[0] + acc[1]) + (acc[2] + acc[3])) + ((acc[4] + acc[5]) + (acc[6] + acc[7]));
        if (act == 2) { a = fmaxf(a, 0.f); a = a * a; }
        outv[n] = a; }
    __syncthreads();
}
constexpr size_t WS_T0 = WS_CTL + 65536;
constexpr int T0_H = 0, T0_U = 8192, T0_Z = 16384, T0_MIX = 49152, T0_Y = 57344;
__device__ __forceinline__ void t0_skinny(const float* W, int K, int N, const float* in, int ldi, float* outp, int ldo, int act, LAS unsigned char* lds, int tid) {
    const int CW = N >= 2048 ? 16 : 4, NKP = NTHREADS / CW, KS = K / NKP;
    const int c = tid % CW, kp = tid / CW, col = blockIdx.x * CW + c;
    if (blockIdx.x * CW >= N) return;
    float acc[8];
#pragma unroll
    for (int r = 0; r < 8; ++r) acc[r] = 0.f;
    if (col < N) {
        for (int k = kp * KS; k < (kp + 1) * KS; k += 4) { float w[4];
#pragma unroll
            for (int i = 0; i < 4; ++i) w[i] = W[(size_t)(k + i) * N + col];
#pragma unroll
            for (int r = 0; r < 8; ++r) { const f32x4 x = *(const f32x4*)(in + (size_t)r * ldi + k); acc[r] += x[0] * w[0] + x[1] * w[1] + x[2] * w[2] + x[3] * w[3]; } } }
#pragma unroll
    for (int r = 0; r < 8; ++r) { float a = acc[r]; for (int o = CW; o < 64; o <<= 1) a += __shfl_xor(a, o); acc[r] = a; }
    LAS float* part = (LAS float*)lds;
    if ((tid & 63) < CW) {
#pragma unroll
        for (int r = 0; r < 8; ++r) part[((tid >> 6) * CW + c) * 8 + r] = acc[r]; }
    __syncthreads();
    if (tid < CW * 8) { const int cc = tid >> 3, r = tid & 7; float a = 0.f;
#pragma unroll
        for (int q = 0; q < NWAVES; ++q) a += part[(q * CW + cc) * 8 + r];
        if (act == 2) { a = fmaxf(a, 0.f); a = a * a; }
        const int n = blockIdx.x * CW + cc; if (n < N) outp[(size_t)r * ldo + n] = a; }
    __syncthreads();
}
__device__ __forceinline__ void t0_load(LAS float* dst, const float* src, int n, int tid) { for (int i = tid; i < n; i += NTHREADS) dst[i] = src[i]; __syncthreads(); }
__device__ __forceinline__ void t0_store(float* dst, const LAS float* src, int n, int tid) { for (int i = tid; i < n; i += NTHREADS) dst[i] = src[i]; __syncthreads(); }

__device__ __forceinline__ void t0_mix_even(const Params& p, int li, const LAS float* z, LAS float* mix, LAS float* sc, int tid) {
            if (tid < 4 * 64) { const int hh = tid >> 6, l = tid & 63; float a = z[hh * 128 + l] * z[512 + hh * 128 + l] + z[hh * 128 + 64 + l] * z[512 + hh * 128 + 64 + l];
                float v2 = z[1024 + hh * 128 + l] * z[1024 + hh * 128 + l] + z[1024 + hh * 128 + 64 + l] * z[1024 + hh * 128 + 64 + l];
                a = wave_sum(a) * 0.08838834764831845f; v2 = wave_sum(v2); if (l == 0) { sc[2 * hh] = a; sc[2 * hh + 1] = a * a * v2 * (1.f / 128.f); } }
            __syncthreads();
            { const int hh = tid >> 7, e = tid; const float sv = sc[2 * hh], r = rsqrtf(sc[2 * hh + 1] + EPS), gt = z[1536 + e];
              mix[e] = sv * z[1024 + e] * r * p.ev_ret_norm_g[li * 512 + e] * (gt / (1.f + expf(-gt))); }
            { const int hq = tid >> 6, l = tid & 63, kv = hq >> 2; float a = wave_sum(z[2048 + hq * 64 + l] * z[2560 + kv * 64 + l]) * 0.125f;
              const float sink = p.ev_sinks[li * 8 + hq], m = fmaxf(a, sink), pe = expf(a - m), den = pe + expf(sink - m);
              mix[512 + hq * 64 + l] = (pe / den) * z[2688 + kv * 64 + l]; }
            __syncthreads();
}
__device__ __forceinline__ void t0_mix_odd(const Params& p, int li, const LAS float* z, LAS float* mix, LAS float* sc, int tid) {
            if (tid < 4 * 64) { const int hh = tid >> 6, l = tid & 63; float a = z[hh * 128 + l] * z[512 + hh * 128 + l] + z[hh * 128 + 64 + l] * z[512 + hh * 128 + 64 + l];
                float v2 = 0.f;
#pragma unroll
                for (int q = 0; q < 4; ++q) { const float vv = z[1024 + hh * 256 + q * 64 + l]; v2 += vv * vv; }
                a = wave_sum(a) * 0.08838834764831845f; v2 = wave_sum(v2); if (l == 0) { sc[2 * hh] = a; sc[2 * hh + 1] = a * a * v2 * (1.f / 256.f); } }
            __syncthreads();
#pragma unroll
            for (int q = 0; q < 2; ++q) { const int e = tid + 512 * q, hh = e >> 8; const float sv = sc[2 * hh], r = rsqrtf(sc[2 * hh + 1] + EPS), gt = z[2048 + e];
                mix[e] = sv * z[1024 + e] * r * p.od_norm_g[li * 1024 + e] * (gt / (1.f + expf(-gt))); }
            __syncthreads();
}
__device__ __forceinline__ void t0_path(const Params& p, LAS unsigned char* lds, int b, int tid, int nlayers = DEPTH) {
    LAS float* h = (LAS float*)lds; LAS float* u = h + 1024; LAS float* z = u + 1024; LAS float* mix = z + 4096; LAS float* y = mix + 1024; LAS float* red = y + 1024; LAS float* sc = red + 16;
    h[tid] = p.x[(size_t)b * T * D + tid]; h[tid + 512] = p.x[(size_t)b * T * D + tid + 512];
    __syncthreads();
#pragma unroll 1
    for (int layer = 0; layer < nlayers; ++layer) { const int li = layer >> 1; const float* ng = p.norm_g + (size_t)layer * 4 * D;
        t0_rmsnorm_<false>(h, ng, u, red, tid);
        if (!(layer & 1)) {
            t0_gemv(p.ev_w_in + (size_t)li * 1024 * EV_IN, 1024, EV_IN, u, z, 0, tid);
            t0_mix_even(p, li, z, mix, sc, tid);
            t0_gemv(p.ev_w_out + (size_t)li * 1024 * 1024, 1024, 1024, mix, y, 0, tid);
        } else {
            t0_gemv(p.od_w_in + (size_t)li * 1024 * OD_IN, 1024, OD_IN, u, z, 0, tid);
            t0_mix_odd(p, li, z, mix, sc, tid);
            t0_gemv(p.od_w_out + (size_t)li * 1024 * 1024, 1024, 1024, mix, y, 0, tid);
        }
        t0_rmsnorm_<true>(y, ng + D, h, red, tid);
        t0_rmsnorm_<false>(h, ng + 2 * D, u, red, tid);
        t0_gemv(p.w_up + (size_t)layer * 1024 * FF, 1024, FF, u, z, 2, tid);
        t0_gemv(p.w_down + (size_t)layer * FF * 1024, FF, 1024, z, y, 0, tid);
        t0_rmsnorm_<true>(y, ng + 3 * D, h, red, tid);
    }
#ifdef DBG_T0CMP
    { const float d0 = fabsf(p.out[(size_t)b * T * D + tid] - h[tid]), d1 = fabsf(p.out[(size_t)b * T * D + tid + 512] - h[tid + 512]);
      if (d0 > DBG_T0CMP || d1 > DBG_T0CMP) p.out[(size_t)b * T * D + tid] = __builtin_nanf(""); }
#else
    p.out[(size_t)b * T * D + tid] = h[tid]; p.out[(size_t)b * T * D + tid + 512] = h[tid + 512];
#endif
}

struct XcdOrder {
    int nN, nu, NL, bx, rk, blk;
    __device__ void init(int N, int G, int c) { nN = N / pg8::BM; nu = 16 * nN; NL = G >> 3; bx = c & 7; rk = c >> 3; blk = (NL == 32) ? 1 : 0; }
    __device__ bool next(int i, pg8::Unit& u) const {
        if (blk) { if (nN == 13 && i >= 6) { if (i > 6 || rk >= 16) return false; u.pm = bx * 16 + rk; u.pn = 12; return true; }
            const int pn = 4 * (i >> 1) + (rk >> 3); if (pn >= nN) return false; u.pm = bx * 16 + 8 * ((i ^ (i >> 1)) & 1) + (rk & 7); u.pn = pn; return true; }
        const int L = i * NL + rk; if (L >= nu) return false; u.pm = bx * 16 + (L & 15); u.pn = L >> 4; return true; }
    __device__ __forceinline__ void a_ready(const pg8::Unit&) const {}
    __device__ __forceinline__ void done(const pg8::Unit&) const {}
};
#ifndef PG8_ALIGN_OPT
#define PG8_ALIGN_OPT true
#endif
#ifndef PG8_SP2_OPT
#define PG8_SP2_OPT true
#endif
#define GAS __attribute__((address_space(1)))
#define XB_TMO      128
#define XB_XCNT(j)  (256  + 64 * (j))
#define XB_XSUB(j)  (1280 + 64 * (j))
#define XB_XGEN(j)  (2304 + 64 * (j))
#define XB_TOP      3328
#define XB_TOPGEN   3392
#define XCD_BAR_WORDS 3456
#define XB_SPIN_CAP (1u << 18)

__device__ __forceinline__ unsigned xb_ld(unsigned* p)              { return __hip_atomic_load(p, __ATOMIC_RELAXED, __HIP_MEMORY_SCOPE_AGENT); }
__device__ __forceinline__ unsigned xb_add(unsigned* p, unsigned v) { return __hip_atomic_fetch_add(p, v, __ATOMIC_RELAXED, __HIP_MEMORY_SCOPE_AGENT); }
__device__ __forceinline__ unsigned xb_xcc_id() { return (unsigned)__builtin_amdgcn_s_getreg((3 << 11) | 20) & 0xFu; }
#define XB_SPIN(cond, bar) do { unsigned _sp = 0; while (cond) { __builtin_amdgcn_s_sleep(1); \
    if ((++_sp & 255u) == 0u) { if (xb_ld(&(bar)[XB_TMO])) break; if (_sp > XB_SPIN_CAP) { atomicAdd(&(bar)[XB_TMO], 1u); break; } } } } while (0)

struct XcdBarrier {
    unsigned* bar; unsigned x;
    volatile LAS unsigned* st;
};

__device__ __forceinline__ XcdBarrier xcd_barrier_post(unsigned* bar, volatile LAS unsigned* st) {
    XcdBarrier b; b.bar = bar; b.x = xb_xcc_id(); b.st = st;
    if (threadIdx.x == 0) (void)xb_add(&bar[XB_XCNT(b.x)], 1u);
    return b;
}
__device__ __forceinline__ void xcd_barrier_complete(unsigned* bar, unsigned x, unsigned& nloc, unsigned& nx) {
    const unsigned G = gridDim.x * gridDim.y * gridDim.z;
    unsigned sum, cnt, mine, sp = 0u;
    for (;;) {
        sum = 0u; cnt = 0u; mine = 0u;
#pragma unroll
        for (unsigned j = 0; j < 16; ++j) { const unsigned c = xb_ld(&bar[XB_XCNT(j)]); sum += c; cnt += (c > 0u) ? 1u : 0u; mine = (j == x) ? c : mine; }
        if (sum == G) break;
        __builtin_amdgcn_s_sleep(1);
        if ((++sp & 255u) == 0u) { if (xb_ld(&bar[XB_TMO])) break; if (sp > XB_SPIN_CAP) { atomicAdd(&bar[XB_TMO], 1u); break; } }
    }
    nloc = mine > 0u ? mine : 1u; nx = cnt > 0u ? cnt : 1u;
}

__device__ __forceinline__ void xcd_barrier(const XcdBarrier& b) {
    asm volatile("s_waitcnt vmcnt(0)" ::: "memory");
    __syncthreads();
    if (threadIdx.x == 0) {
        unsigned* bar = b.bar;
        __builtin_amdgcn_s_waitcnt(0);
        unsigned nloc = b.st[0], nx = b.st[1];
        if (nloc == 0u) { xcd_barrier_complete(bar, b.x, nloc, nx); b.st[0] = nloc; b.st[1] = nx; }
        const unsigned old = xb_add(&bar[XB_XSUB(b.x)], 1u);
        const unsigned gen = old / nloc;
        if (old + 1u == (gen + 1u) * nloc) {
            __builtin_amdgcn_fence(__ATOMIC_RELEASE, "agent");
            asm volatile("s_waitcnt vmcnt(0)" ::: "memory");
            const unsigned og = xb_add(&bar[XB_TOP], 1u);
            const unsigned tg = og / nx;
            if (og + 1u == (tg + 1u) * nx) xb_add(&bar[XB_TOPGEN], 1u);
            else XB_SPIN(xb_ld(&bar[XB_TOPGEN]) == tg, bar);
            __builtin_amdgcn_fence(__ATOMIC_ACQUIRE, "agent");
            xb_add(&bar[XB_XGEN(b.x)], 1u);
            asm volatile("s_waitcnt vmcnt(0)" ::: "memory");
        } else {
            XB_SPIN(xb_ld(&bar[XB_XGEN(b.x)]) == gen, bar);
            __builtin_amdgcn_fence(__ATOMIC_ACQUIRE, "agent");
            asm volatile("s_waitcnt vmcnt(0)" ::: "memory");
        }
    }
    __syncthreads();
}

#define GRID_SYNC() xcd_barrier(xbar)
__global__ void __launch_bounds__(NTHREADS, 2) mega_fwd(Params p) {
    extern __shared__ __attribute__((aligned(16))) unsigned char lds_raw[];
    LAS unsigned char* lds = (LAS unsigned char*)lds_raw;
    cg::grid_group grid = cg::this_grid();
    const int G = gridDim.x;
#ifdef DBG_DELAY_US
#pragma unroll 1
    for (int dly = 0; dly < DBG_DELAY_US / 3; ++dly) __builtin_amdgcn_s_sleep(127);
#endif
    volatile LAS unsigned* xst = (volatile LAS unsigned*)(lds + LDS_BYTES - 16);
    if (threadIdx.x < 2) xst[threadIdx.x] = 0u;
    __syncthreads();
    const XcdBarrier xbar = xcd_barrier_post((unsigned*)(p.ws + WS_CTL), xst);
    if (p.s_lo == 0) {
        {   int tid = threadIdx.x; asm volatile("" : "+v"(tid)); const int lane = tid & 63, wave = __builtin_amdgcn_readfirstlane(tid >> 6);
            prologue_phase(p, lds, tid, wave, lane);
            if (blockIdx.x < NB) {
                __syncthreads(); float* T0 = (float*)(p.ws + WS_T0); const int b = blockIdx.x;
                LAS float* h = (LAS float*)lds; LAS float* u = h + 1024; LAS float* red = h + 8192;
                t0_load(h, p.x + (size_t)b * T * D, 1024, tid); t0_rmsnorm_<false>(h, p.norm_g, u, red, tid);
                t0_store(T0 + T0_H + b * 1024, h, 1024, tid); t0_store(T0 + T0_U + b * 1024, u, 1024, tid); } }
        if (p.s_hi > 1) {
            asm volatile("s_waitcnt vmcnt(0) lgkmcnt(0)" ::: "memory"); __syncthreads();
            grid.sync();
            GRID_SYNC();
        }
    }

#pragma unroll 1
    for (int layer_i = 0; layer_i < DEPTH; ++layer_i) {
#pragma unroll 1
        for (int ph = 0; ph < 9; ++ph) {
            const int step = 1 + layer_i * 9 + ph; if (step < p.s_lo || step >= p.s_hi) continue;
            int layer = layer_i; asm volatile("" : "+s"(layer));
            const int li = layer >> 1; const bool odd = layer & 1;
            int tid = threadIdx.x; asm volatile("" : "+v"(tid)); const int lane = tid & 63, wave = __builtin_amdgcn_readfirstlane(tid >> 6);
            const int gw = blockIdx.x * NWAVES + wave, NGW = G * NWAVES;
            int wv = tid >> 6; asm volatile("" : "+v"(wv));
            const int bx = blockIdx.x & 7, rk = blockIdx.x >> 3, NL = G >> 3;
            unsigned char* ws = p.ws; asm volatile("" : "+s"(ws));
            bf16_t* U = (bf16_t*)(ws + WS_U); bf16_t* MIX = (bf16_t*)(ws + WS_MIX); bf16_t* Zb = (bf16_t*)(ws + WS_Z);
            {
                float* T0 = (float*)(ws + WS_T0); const float* ngl = p.norm_g + (size_t)layer * 4 * D; const int b = blockIdx.x;
                LAS float* h = (LAS float*)lds; LAS float* u = h + 1024; LAS float* z = u + 1024; LAS float* mix = z + 4096; LAS float* y = mix + 1024; LAS float* red = y + 1024; LAS float* sc = red + 16;
                if (ph == 0) t0_skinny(odd ? p.od_w_in + (size_t)li * 1024 * OD_IN : p.ev_w_in + (size_t)li * 1024 * EV_IN, 1024, odd ? OD_IN : EV_IN, T0 + T0_U, 1024, T0 + T0_Z, 4096, 0, lds, tid);
                else if (ph == 4) t0_skinny((odd ? p.od_w_out : p.ev_w_out) + (size_t)li * 1024 * 1024, 1024, 1024, T0 + T0_MIX, 1024, T0 + T0_Y, 1024, 0, lds, tid);
                else if (ph == 6) t0_skinny(p.w_up + (size_t)layer * 1024 * FF, 1024, FF, T0 + T0_U, 1024, T0 + T0_Z, 4096, 2, lds, tid);
                else if (ph == 7) t0_skinny(p.w_down + (size_t)layer * FF * 1024, FF, 1024, T0 + T0_Z, 4096, T0 + T0_Y, 1024, 0, lds, tid);
                else if (b < NB && ph == 1) { t0_load(z, T0 + T0_Z + b * 4096, 4096, tid); if (odd) t0_mix_odd(p, li, z, mix, sc, tid); else t0_mix_even(p, li, z, mix, sc, tid);
                    t0_store(T0 + T0_MIX + b * 1024, mix, 1024, tid); }
                else { }
            }
            if (ph == 0 || ph == 4 || ph == 6 || ph == 7) {
                pg8::Gemm g; pg8::EpiSt E; E.Of0 = nullptr; E.Of1 = nullptr;
                if (ph == 0) { g.A = layer == 0 ? U : (const bf16_t*)(ws + WS_ST); g.K = 1024; E.O = Zb; E.act = 0;
                    if (!odd) { g.Bt = (const bf16_t*)(ws + WS_EVIN) + (size_t)li * EV_IN * 1024; g.N = EV_IN; E.ldc = EV_IN; E.nvalid = EV_IN; }
                    else { g.Bt = (const bf16_t*)(ws + WS_ODIN) + (size_t)li * OD_INP * 1024; g.N = OD_INP; E.ldc = OD_LD; E.nvalid = OD_IN; } }
                else if (ph == 4) { g.A = MIX; g.K = 1024; g.N = 1024; g.Bt = (const bf16_t*)(ws + (odd ? WS_ODOUT : WS_EVOUT)) + (size_t)li * 1024 * 1024; E.O = U; E.ldc = 1024; E.nvalid = 1024; E.act = 0; E.Of0 = (float*)Zb; }
                else if (ph == 6) { g.A = U; g.K = 1024; g.N = FF; g.Bt = (const bf16_t*)(ws + WS_UP) + (size_t)layer * FF * 1024; E.O = Zb; E.ldc = FF; E.nvalid = FF; E.act = 2; }
                else { g.A = Zb; g.K = FF; g.N = 1024; g.Bt = (const bf16_t*)(ws + WS_DN) + (size_t)layer * 1024 * FF; E.O = U; E.ldc = 1024; E.nvalid = 1024; E.act = 0; E.Of0 = (float*)MIX; }
                g.M = M;
                XcdOrder S; S.init(g.N, G, (int)blockIdx.x);
                pg8::gemm_phase<pg8::EpiSt, XcdOrder, PG8_ALIGN_OPT, PG8_SP2_OPT>(lds, g, S, E);
#ifdef PROBE_DOUBLE_GEMM
                __syncthreads(); pg8::gemm_phase<pg8::EpiSt, XcdOrder, PG8_ALIGN_OPT, PG8_SP2_OPT>(lds, g, S, E);
#endif
            }
#ifndef NO_MIX
            else if (ph == 1) {
#ifdef PROBE_DOUBLE_MIX
              for (int rep = 0; rep < 2; ++rep)
#endif
              {
                if (!odd) { for (int ul = rk; ul < 128 + 64; ul += NL) { if (ul < 128) la1_unit<false>(lds, p, li, bx * 128 + ul, 0, tid, wv, lane);
                                else { const int s = ul - 128; swa_unit(lds, Zb, MIX, p.ev_sinks + li * 8, bx, (s >> 5) & 1, s & 31, tid, wv, lane); } } }
                else { for (int ul = rk; ul < 128; ul += NL) la1_unit<true>(lds, p, li, bx * 128 + ul, 0, tid, wv, lane); }
              }
            } else if (ph == 2) {
                if (!odd) la2_phase<false>(p, tid, bx, rk, NL); else la2_phase<true>(p, tid, bx, rk, NL);
            } else if (ph == 3) {
#ifdef PROBE_DOUBLE_MIX
              for (int rep = 0; rep < 2; ++rep)
#endif
              {
                if (!odd) { for (int ul = rk; ul < 128; ul += NL) la3_unit<false>(lds, p, li, bx * 128 + ul, tid, wv, lane); }
                else { for (int ul = rk; ul < 128; ul += NL) la3_unit<true>(lds, p, li, bx * 128 + ul, tid, wv, lane); }
              }
            }
#endif
            else if (ph == 5) {
                norm_phase((const float*)Zb, nullptr, layer == 0 ? p.x : p.out, p.out, p.norm_g + (layer * 4 + 1) * D, p.norm_g + (layer * 4 + 2) * D, U, gw, NGW, lane, (float*)(ws + WS_T0), false);
            } else {
                norm_phase((const float*)MIX, nullptr, p.out, p.out, p.norm_g + (layer * 4 + 3) * D, layer + 1 < DEPTH ? p.norm_g + ((layer + 1) * 4) * D : nullptr, (bf16_t*)(ws + WS_ST), gw, NGW, lane, (float*)(ws + WS_T0), layer + 1 == DEPTH);
            }
            if (step + 1 < p.s_hi) GRID_SYNC();
#ifdef PROBE_DOUBLE_BAR
            if (step + 1 < p.s_hi) GRID_SYNC();
#endif
        }
    }
    if (p.s_hi > 1 + 9 * DEPTH) {
        if (blockIdx.x < NB) { const float* T0 = (const float*)(p.ws + WS_T0); for (int i = threadIdx.x; i < D; i += NTHREADS) p.out[(size_t)blockIdx.x * T * D + i] = T0[T0_H + blockIdx.x * 1024 + i]; }
    }
}

#ifdef DBG_SEPK
__global__ void __launch_bounds__(NTHREADS, 2) k_mix1_even(Params p, int li) {
    extern __shared__ __attribute__((aligned(16))) unsigned char lds_raw2[];
    LAS unsigned char* lds = (LAS unsigned char*)lds_raw2;
    const int tid = threadIdx.x, lane = tid & 63, wave = __builtin_amdgcn_readfirstlane(tid >> 6);
    const int bx = blockIdx.x & 7, rk = blockIdx.x >> 3, NL = gridDim.x >> 3;
    bf16_t* MIX = (bf16_t*)(p.ws + WS_MIX); bf16_t* Zb = (bf16_t*)(p.ws + WS_Z);
    for (int ul = rk; ul < 128 + 64; ul += NL) { if (ul < 128) la1_unit<false>(lds, p, li, bx * 128 + ul, 0, tid, wv, lane);
        else { const int s = ul - 128; swa_unit(lds, Zb, MIX, p.ev_sinks + li * 8, bx, (s >> 5) & 1, s & 31, tid, wv, lane); } }
}
#endif
#ifdef DBG_T0CHK
__global__ void __launch_bounds__(NTHREADS, 2) k_t0chk(Params p) {
    extern __shared__ __attribute__((aligned(16))) unsigned char lds_raw3[];
    LAS unsigned char* lds = (LAS unsigned char*)lds_raw3; const int tid = threadIdx.x, b = blockIdx.x;
    LAS float* h = (LAS float*)lds; LAS float* u = h + 1024; LAS float* z = u + 1024; LAS float* red = z + 4096 + 2048;
    h[tid] = p.x[(size_t)b * T * D + tid]; h[tid + 512] = p.x[(size_t)b * T * D + tid + 512]; __syncthreads();
    t0_rmsnorm_<false>(h, p.norm_g, u, red, tid);
    t0_gemv(p.ev_w_in, 1024, EV_IN, u, z, 0, tid);
    const bf16_t* Zr = (const bf16_t*)(p.ws + WS_Z) + (size_t)b * T * EV_IN; const bf16_t* Ur = (const bf16_t*)(p.ws + WS_U) + (size_t)b * T * D;
    bool bad = false;
    for (int n = tid; n < EV_IN; n += NTHREADS) { const float zm = __uint_as_float((unsigned)Zr[n] << 16); if (fabsf(zm - z[n]) > 0.05f + 0.02f * fabsf(zm)) bad = true; }
    if (DBG_T0CHK == 3) { bad = false; for (int n = tid; n < D; n += NTHREADS) { const float um = __uint_as_float((unsigned)Ur[n] << 16); if (fabsf(um - u[n]) > 0.02f + 0.01f * fabsf(um)) bad = true; } }
    if (DBG_T0CHK >= 10) { t0_path(p, lds, b, tid, DBG_T0CHK - 10); return; }
    if (DBG_T0CHK == 2) { LAS float* mix = z + 4096; LAS float* sc = red + 16; t0_mix_even(p, 0, z, mix, sc, tid);
        const bf16_t* Mr = (const bf16_t*)(p.ws + WS_MIX) + (size_t)b * T * D; bad = false;
        for (int n = tid; n < D; n += NTHREADS) { const float mm = __uint_as_float((unsigned)Mr[n] << 16); if (fabsf(mm - mix[n]) > 0.05f + 0.05f * fabsf(mm)) bad = true; } }
    if (DBG_T0CHK == 5) { LAS float* mix = z + 4096; LAS float* sc = red + 16; LAS float* y = mix + 1024; t0_mix_even(p, 0, z, mix, sc, tid);
        t0_gemv(p.ev_w_out, 1024, 1024, mix, y, 0, tid); bad = false;
        for (int n = tid; n < D; n += NTHREADS) { const float um = __uint_as_float((unsigned)Ur[n] << 16); if (fabsf(um - y[n]) > 0.03f + 0.05f * fabsf(um)) bad = true; } }
    if (DBG_T0CHK == 6) { LAS float* mix = z + 4096; LAS float* sc = red + 16; LAS float* y = mix + 1024; t0_mix_even(p, 0, z, mix, sc, tid);
        t0_gemv(p.ev_w_out, 1024, 1024, mix, y, 0, tid); t0_rmsnorm_<true>(y, p.norm_g + D, h, red, tid); t0_rmsnorm_<false>(h, p.norm_g + 2 * D, u, red, tid); bad = false;
        for (int n = tid; n < D; n += NTHREADS) { const float hm = p.out[(size_t)b * T * D + n]; if (fabsf(hm - h[n]) > 0.03f + 0.03f * fabsf(hm)) bad = true;
            const float um = __uint_as_float((unsigned)Ur[n] << 16); if (fabsf(um - u[n]) > 0.03f + 0.03f * fabsf(um)) bad = true; } }
    __syncthreads();
    if (bad) p.out[(size_t)(b * T + T - 1) * D + tid] = __builtin_nanf("");
}
#endif
#ifdef DBG_STEPS
__global__ void dbg_dump(Params p) {
    const bf16_t* src = (const bf16_t*)(p.ws + (size_t)DBG_OFF_MIB * MiB);
    for (size_t idx = (size_t)blockIdx.x * blockDim.x + threadIdx.x; idx < (size_t)M * D; idx += (size_t)gridDim.x * blockDim.x) { const size_t m = idx >> 10, c = idx & 1023;
#ifndef DBG_W
#define DBG_W 1024
#endif
        p.out[idx] = c < DBG_W ? __uint_as_float((unsigned)src[m * DBG_LD + DBG_COL + c] << 16) : 0.f; }
}
#endif
extern "C" void kernel_launch(void* const* d_in, const int* in_sizes, int n_in, void* d_out, int out_size, void* d_ws, size_t ws_size, hipStream_t stream) {
    static int grid = 0;
    if (grid == 0) {
        if (n_in != 13 || in_sizes[0] != M * D || out_size != M * D || ws_size < WS_END) { fprintf(stderr, "kernel_launch: unexpected shapes / workspace (n_in %d, ws %zu)\n", n_in, ws_size); grid = -1; return; }
        int dev = 0, cus = 0, per_cu = 0;
        hipGetDevice(&dev); hipDeviceGetAttribute(&cus, hipDeviceAttributeMultiprocessorCount, dev);
        if (hipFuncSetAttribute((const void*)mega_fwd, hipFuncAttributeMaxDynamicSharedMemorySize, LDS_BYTES) != hipSuccess) { fprintf(stderr, "kernel_launch: hipFuncSetAttribute failed\n"); grid = -1; return; }
        if (hipOccupancyMaxActiveBlocksPerMultiprocessor(&per_cu, (const void*)mega_fwd, NTHREADS, LDS_BYTES) != hipSuccess || per_cu < 1) { fprintf(stderr, "kernel_launch: occupancy query gave %d\n", per_cu); per_cu = 1; }
        (void)hipGetLastError();
        grid = cus * per_cu;
    }
    if (grid < 0) return;
    Params p{};
    p.x = (const float*)d_in[0]; p.norm_g = (const float*)d_in[1]; p.w_up = (const float*)d_in[2]; p.w_down = (const float*)d_in[3]; p.ev_w_in = (const float*)d_in[4];
    p.ev_ret_norm_g = (const float*)d_in[5]; p.ev_sinks = (const float*)d_in[6]; p.ev_w_out = (const float*)d_in[7]; p.od_w_in = (const float*)d_in[8]; p.od_w_gate_up = (const float*)d_in[9];
    p.od_gate_bias = (const float*)d_in[10]; p.od_norm_g = (const float*)d_in[11]; p.od_w_out = (const float*)d_in[12];
    p.out = (float*)d_out; p.ws = (unsigned char*)d_ws;
    if (hipMemsetAsync((char*)d_ws + WS_CTL, 0, 16384, stream) != hipSuccess) { fprintf(stderr, "kernel_launch: memset failed\n"); return; }
#ifndef MK_PER_PHASE
#define MK_PER_PHASE 0
#endif
    constexpr int NSTEPS = 1 + 9 * DEPTH;
    if (MK_PER_PHASE) {
#ifdef DBG_STEPS
#ifndef DBG_SKIP_LO
#define DBG_SKIP_LO 0
#define DBG_SKIP_HI 0
#endif
#ifdef DBG_SEPK
        hipFuncSetAttribute((const void*)k_mix1_even, hipFuncAttributeMaxDynamicSharedMemorySize, LDS_BYTES);
#endif
        for (int st = 0; st < DBG_STEPS; ++st) { if (st >= DBG_SKIP_LO && st < DBG_SKIP_HI) continue; p.s_lo = st; p.s_hi = st + 1;
#ifdef DBG_SEPK
            if (st == 2) { hipLaunchKernelGGL(k_mix1_even, dim3(grid), dim3(NTHREADS), LDS_BYTES, stream, p, 0); continue; }
#endif
            hipLaunchKernelGGL(mega_fwd, dim3(grid), dim3(NTHREADS), LDS_BYTES, stream, p); }
#ifndef DBG_NODUMP
        hipLaunchKernelGGL(dbg_dump, dim3(2048), dim3(256), 0, stream, p);
#endif
#ifdef DBG_T0CHK
        hipLaunchKernelGGL(k_t0chk, dim3(8), dim3(NTHREADS), 65536, stream, p);
#endif
#else
        for (int st = 0; st < NSTEPS; ++st) { p.s_lo = st; p.s_hi = st + 1; hipLaunchKernelGGL(mega_fwd, dim3(grid), dim3(NTHREADS), LDS_BYTES, stream, p); }
#endif
    } else {
        p.s_lo = 0; p.s_hi = NSTEPS;
        void* args[] = {&p};
        hipError_t e = hipLaunchCooperativeKernel((const void*)mega_fwd, dim3(grid), dim3(NTHREADS), args, LDS_BYTES, stream);
        if (e != hipSuccess) fprintf(stderr, "kernel_launch: cooperative launch failed: %s (grid %d)\n", hipGetErrorString(e), grid);
    }
}
```

```cpp
#include <hip/hip_runtime.h>
#include <cstdio>
#include <cstdint>
#include <cmath>
namespace pg8 {
#define PG8_LAS __attribute__((address_space(3)))
typedef unsigned short bf16_t;
typedef short bf16x8 __attribute__((ext_vector_type(8)));
typedef float f32x4 __attribute__((ext_vector_type(4)));
typedef unsigned u32x4 __attribute__((ext_vector_type(4)));
constexpr int BM = 256, BK = 64, HALF = 128, HTB = HALF * BK * 2  , STAGE_BYTES = 8 * HTB, NXCD = 8, WGM = 8;

__host__ __device__ __forceinline__ int lds_byte(int r, int c) { const int st = (r >> 4) * 2 + (c >> 5), rr = r & 15, cc = c & 31, ob = rr * 64 + cc * 2; return st * 1024 + (ob ^ (((ob >> 9) & 1) << 5)); }
__host__ __device__ __forceinline__ void stage_rc(int b, int& R, int& C) { const int st = b / 1024, sb = b % 1024, swz = sb ^ (((sb >> 9) & 1) << 5); R = (st >> 1) * 16 + swz / 64; C = (st & 1) * 32 + (swz % 64) / 2; }
__host__ __device__ __forceinline__ int perm32(int rho) { const int n = rho >> 4, i = rho & 15; return 8 * (i >> 2) + 4 * n + (i & 3); }

struct Unit { int pm, pn; };
struct Gemm { const bf16_t* A; const bf16_t* Bt; int M, N, K; };

struct StaticOrder {
    int nM, nN, nwg, G, c;
    __host__ __device__ void init(int M, int N, int G_, int c_) { nM = M / BM; nN = N / BM; nwg = nM * nN; G = G_; c = c_; }
    __host__ __device__ bool next(int i, Unit& u) const {
        const long L = (long)i * G + c; if (L >= nwg) return false;
        int wgid = (int)L; { const int q = nwg / NXCD, r = nwg % NXCD, xcd = wgid % NXCD, off = wgid / NXCD; wgid = (xcd < r ? xcd * (q + 1) : r * (q + 1) + (xcd - r) * q) + off; }
        const int nig = WGM * nN, gid = wgid / nig, fm = gid * WGM, gsz = (nM - fm) < WGM ? (nM - fm) : WGM;
        u.pm = fm + ((wgid % nig) % gsz); u.pn = (wgid % nig) / gsz; return true;
    }
    __device__ __forceinline__ void a_ready(const Unit&) const {}
    __device__ __forceinline__ void done(const Unit&) const {}
};

typedef __bf16 bf16x2_t __attribute__((ext_vector_type(2)));
typedef float f32x2_t __attribute__((ext_vector_type(2)));
__device__ __forceinline__ unsigned cvt_pk_bf16(float lo, float hi) { const f32x2_t v = {lo, hi}; const bf16x2_t b = __builtin_convertvector(v, bf16x2_t); return __builtin_bit_cast(unsigned, b); }
struct EpiSt {
    static constexpr bool PERM = true, AFTER_DRAIN = false;
    bf16_t* O; int ldc; int nvalid; int act; float* Of0; float* Of1;
    __device__ __forceinline__ void operator()(const f32x4 (&acc)[2][2][4][2], const Unit& u, int wr, int wc, int fr, int fq) const {
        const int row0 = u.pm * BM + wr * 64 + fr; const int col0 = u.pn * BM + wc * 32 + 8 * fq;
        if (Of0) {
            typedef _Float16 h2_t __attribute__((ext_vector_type(2))); typedef float f2_t __attribute__((ext_vector_type(2)));
            unsigned short* Oh = (unsigned short*)Of0;
#pragma unroll
            for (int ai = 0; ai < 2; ++ai)
#pragma unroll
                for (int m = 0; m < 4; ++m) { unsigned short* rowp = Oh + (size_t)(row0 + ai * HALF + m * 16) * 1024 + col0;
#pragma unroll
                    for (int bj = 0; bj < 2; ++bj) { const f32x4 v0 = acc[ai][bj][m][0], v1 = acc[ai][bj][m][1]; u32x4 w;
                        w.x = __builtin_bit_cast(unsigned, __builtin_convertvector((f2_t){v0[0], v0[1]}, h2_t)); w.y = __builtin_bit_cast(unsigned, __builtin_convertvector((f2_t){v0[2], v0[3]}, h2_t));
                        w.z = __builtin_bit_cast(unsigned, __builtin_convertvector((f2_t){v1[0], v1[1]}, h2_t)); w.w = __builtin_bit_cast(unsigned, __builtin_convertvector((f2_t){v1[2], v1[3]}, h2_t));
                        *(u32x4*)(rowp + bj * HALF) = w; } }
            return;
        }
#pragma unroll
        for (int ai = 0; ai < 2; ++ai)
#pragma unroll
            for (int m = 0; m < 4; ++m) { bf16_t* rowp = O + (size_t)(row0 + ai * HALF + m * 16) * ldc + col0;
#pragma unroll
                for (int bj = 0; bj < 2; ++bj) { f32x4 v0 = acc[ai][bj][m][0], v1 = acc[ai][bj][m][1];
                    if (act == 2) {
#pragma unroll
                        for (int e = 0; e < 4; ++e) { const float a = fmaxf(v0[e], 0.f), b = fmaxf(v1[e], 0.f); v0[e] = a * a; v1[e] = b * b; } }
                    u32x4 w; w.x = cvt_pk_bf16(v0[0], v0[1]); w.y = cvt_pk_bf16(v0[2], v0[3]); w.z = cvt_pk_bf16(v1[0], v1[1]); w.w = cvt_pk_bf16(v1[2], v1[3]);
                    if (col0 + bj * HALF + 8 <= nvalid) *(u32x4*)(rowp + bj * HALF) = w; } }
    }
};

template <class Epi, class Sched, bool ALIGN_EPI = false, bool SP2 = false>
__device__ __forceinline__ void gemm_phase(PG8_LAS unsigned char* lds, const Gemm g, const Sched& S, const Epi& E) {
    int tid = threadIdx.x; asm volatile("" : "+v"(tid));
    const int wid = __builtin_amdgcn_readfirstlane(tid >> 6), lane = tid & 63, wr = wid >> 2, wc = wid & 3, fr = lane & 15, fq = lane >> 4;
    const int K = g.K, nt = K / BK;
    unsigned voffA[2], voffB[2];
#pragma unroll
    for (int i = 0; i < 2; ++i) { int R, C; stage_rc(tid * 16 + i * 8192, R, C); const int Rb = Epi::PERM ? ((R & ~31) + perm32(R & 31)) : R;
        voffA[i] = (unsigned)(R * K + C) * 2u; voffB[i] = (unsigned)(Rb * K + C) * 2u; }
    const size_t kstep = (size_t)(BK * 2);
    const size_t hstep = (size_t)HALF * K * 2;
    const size_t tstep = 2 * hstep;
    const unsigned ldsw = (unsigned)wid * 1024u;
    const int aoff = lds_byte(wr * 64 + fr, fq * 8), boff = lds_byte(wc * 32 + fr, fq * 8);
#define PG8_SA(b, h) (((b) * 2 + (h)) * HTB)
#define PG8_SB(b, h) ((4 + (b) * 2 + (h)) * HTB)
#define PG8_STAGE(bufoff, gbase, voff) do { _Pragma("unroll") for (int _i = 0; _i < 2; ++_i) \
        __builtin_amdgcn_global_load_lds((const unsigned*)((const char*)(gbase) + (voff)[_i]), (PG8_LAS unsigned*)(lds + (bufoff) + ldsw + _i * 8192), 16, 0, 0); } while (0)
#define PG8_LDA(dst, b, h) do { _Pragma("unroll") for (int m = 0; m < 4; ++m) _Pragma("unroll") for (int k = 0; k < 2; ++k) dst[m][k] = *(const PG8_LAS bf16x8*)(lds + PG8_SA(b, h) + aoff + m * 2048 + k * 1024); } while (0)
#define PG8_LDB(dst, b, h) do { _Pragma("unroll") for (int n = 0; n < 2; ++n) _Pragma("unroll") for (int k = 0; k < 2; ++k) dst[n][k] = *(const PG8_LAS bf16x8*)(lds + PG8_SB(b, h) + boff + n * 2048 + k * 1024); } while (0)
#define PG8_MMA(ai, bj, At, Bt) do { __builtin_amdgcn_s_setprio(1); _Pragma("unroll") for (int m = 0; m < 4; ++m) _Pragma("unroll") for (int n = 0; n < 2; ++n) _Pragma("unroll") for (int k = 0; k < 2; ++k) \
        acc[ai][bj][m][n] = __builtin_amdgcn_mfma_f32_16x16x32_bf16(Bt[n][k], At[m][k], acc[ai][bj][m][n], 0, 0, 0); __builtin_amdgcn_s_setprio(0); } while (0)
#define PG8_WAIT_V(n) asm volatile("s_waitcnt vmcnt(" #n ")" ::: "memory")
#define PG8_WAIT_L(n) asm volatile("s_waitcnt lgkmcnt(" #n ")" ::: "memory")
#define PG8_BAR __builtin_amdgcn_s_barrier()
#define PG8_SCHED __builtin_amdgcn_sched_barrier(0)
    Unit cur, nxt; int ui = 0;
    if (!S.next(0, cur)) return;
    f32x4 acc[2][2][4][2];
#pragma unroll
    for (int a = 0; a < 2; ++a)
#pragma unroll
        for (int b = 0; b < 2; ++b)
#pragma unroll
            for (int m = 0; m < 4; ++m)
#pragma unroll
                for (int n = 0; n < 2; ++n) acc[a][b][m][n] = (f32x4){0.f, 0.f, 0.f, 0.f};
    bf16x8 At[4][2], B0[2][2], B1[2][2];
    const char* cA = (const char*)g.A + (size_t)cur.pm * tstep; const char* cB = (const char*)g.Bt + (size_t)cur.pn * tstep;
    S.a_ready(cur);
    if constexpr (SP2) {
        PG8_STAGE(PG8_SB(0, 0), cB, voffB); PG8_STAGE(PG8_SB(0, 1), cB + hstep, voffB); PG8_STAGE(PG8_SA(0, 0), cA, voffA); PG8_STAGE(PG8_SA(0, 1), cA + hstep, voffA);
        if (wr == 1) PG8_BAR;
        PG8_WAIT_V(2); PG8_BAR;
        PG8_STAGE(PG8_SB(1, 0), cB + kstep, voffB); PG8_STAGE(PG8_SA(1, 0), cA + kstep, voffA); PG8_STAGE(PG8_SB(1, 1), cB + hstep + kstep, voffB);
        PG8_WAIT_V(6); PG8_BAR;
    } else {
        PG8_STAGE(PG8_SB(0, 0), cB, voffB); PG8_STAGE(PG8_SA(0, 0), cA, voffA); PG8_STAGE(PG8_SB(0, 1), cB + hstep, voffB); PG8_STAGE(PG8_SA(0, 1), cA + hstep, voffA);
        if (wr == 1) PG8_BAR;
        PG8_WAIT_V(4); PG8_BAR;
        PG8_STAGE(PG8_SB(1, 0), cB + kstep, voffB); PG8_STAGE(PG8_SA(1, 0), cA + kstep, voffA); PG8_STAGE(PG8_SB(1, 1), cB + hstep + kstep, voffB);
        PG8_WAIT_V(6); PG8_BAR;
    }
    for (;;) {
        const bool has_next = S.next(ui + 1, nxt);
        const char* nA = has_next ? (const char*)g.A + (size_t)nxt.pm * tstep : cA; const char* nB = has_next ? (const char*)g.Bt + (size_t)nxt.pn * tstep : cB;
        for (int t = 0; t < nt; t += 2) {
            const bool last = (t == nt - 2);
            const char* a1 = cA + (size_t)(t + 1) * kstep;
            const char* a2 = last ? nA : cA + (size_t)(t + 2) * kstep; const char* b2 = last ? nB : cB + (size_t)(t + 2) * kstep;
            const char* a3 = a2 + kstep; const char* b3 = b2 + kstep;
            if (last && has_next) S.a_ready(nxt);
            if constexpr (SP2) {
            PG8_LDB(B0, 0, 0); PG8_LDB(B1, 0, 1); PG8_SCHED; PG8_LDA(At, 0, 0); PG8_STAGE(PG8_SA(1, 1), a1 + hstep, voffA);
            PG8_WAIT_V(8); PG8_WAIT_L(0); PG8_BAR; PG8_MMA(0, 0, At, B0); PG8_MMA(0, 1, At, B1); PG8_BAR; PG8_SCHED;
            PG8_LDA(At, 0, 1); PG8_STAGE(PG8_SB(0, 0), b2, voffB); PG8_STAGE(PG8_SB(0, 1), b2 + hstep, voffB); PG8_STAGE(PG8_SA(0, 0), a2, voffA);
            PG8_WAIT_V(8); PG8_WAIT_L(0); PG8_BAR; PG8_MMA(1, 0, At, B0); PG8_MMA(1, 1, At, B1); PG8_BAR; PG8_SCHED;
            PG8_LDB(B0, 1, 0); PG8_LDB(B1, 1, 1); PG8_SCHED; PG8_LDA(At, 1, 0); PG8_STAGE(PG8_SA(0, 1), a2 + hstep, voffA);
            PG8_WAIT_V(8); PG8_WAIT_L(0); PG8_BAR; PG8_MMA(0, 0, At, B0); PG8_MMA(0, 1, At, B1); PG8_BAR; PG8_SCHED;
            PG8_LDA(At, 1, 1); PG8_STAGE(PG8_SB(1, 0), b3, voffB); PG8_STAGE(PG8_SB(1, 1), b3 + hstep, voffB); PG8_STAGE(PG8_SA(1, 0), a3, voffA);
            PG8_WAIT_V(8); PG8_WAIT_L(0); PG8_BAR; PG8_MMA(1, 0, At, B0); PG8_MMA(1, 1, At, B1); PG8_BAR; PG8_SCHED;
            } else {
            PG8_LDB(B0, 0, 0); PG8_SCHED; PG8_LDA(At, 0, 0); PG8_STAGE(PG8_SA(1, 1), a1 + hstep, voffA);
            PG8_WAIT_L(8); PG8_BAR; PG8_WAIT_L(0); PG8_MMA(0, 0, At, B0); PG8_BAR; PG8_SCHED;
            PG8_LDB(B1, 0, 1); PG8_STAGE(PG8_SB(0, 0), b2, voffB);
            PG8_BAR; PG8_WAIT_L(0); PG8_MMA(0, 1, At, B1); PG8_BAR;
            PG8_LDA(At, 0, 1); PG8_STAGE(PG8_SA(0, 0), a2, voffA);
            PG8_BAR; PG8_WAIT_L(0); PG8_MMA(1, 0, At, B0); PG8_BAR; PG8_SCHED;
            PG8_STAGE(PG8_SB(0, 1), b2 + hstep, voffB);
            PG8_WAIT_V(6); PG8_BAR; PG8_MMA(1, 1, At, B1); PG8_BAR;
            PG8_LDB(B0, 1, 0); PG8_SCHED; PG8_LDA(At, 1, 0); PG8_STAGE(PG8_SA(0, 1), a2 + hstep, voffA);
            PG8_WAIT_L(8); PG8_BAR; PG8_WAIT_L(0); PG8_MMA(0, 0, At, B0); PG8_BAR; PG8_SCHED;
            PG8_LDB(B1, 1, 1); PG8_STAGE(PG8_SB(1, 0), b3, voffB);
            PG8_BAR; PG8_WAIT_L(0); PG8_MMA(0, 1, At, B1); PG8_BAR;
            PG8_LDA(At, 1, 1); PG8_STAGE(PG8_SA(1, 0), a3, voffA);
            PG8_BAR; PG8_WAIT_L(0); PG8_MMA(1, 0, At, B0); PG8_BAR; PG8_SCHED;
            PG8_STAGE(PG8_SB(1, 1), b3 + hstep, voffB);
            PG8_WAIT_V(6); PG8_BAR; PG8_MMA(1, 1, At, B1); PG8_BAR;
            }
        }
        if constexpr (ALIGN_EPI) { if (wr == 0) PG8_BAR; }
        if constexpr (!Epi::AFTER_DRAIN) { E(acc, cur, wr, wc, fr, fq); S.done(cur); }
        if (!has_next) break;
#pragma unroll
        for (int a = 0; a < 2; ++a)
#pragma unroll
            for (int b = 0; b < 2; ++b)
#pragma unroll
                for (int m = 0; m < 4; ++m)
#pragma unroll
                    for (int n = 0; n < 2; ++n) acc[a][b][m][n] = (f32x4){0.f, 0.f, 0.f, 0.f};
        cur = nxt; cA = nA; cB = nB; ++ui;
        if constexpr (ALIGN_EPI) { if (wr == 1) PG8_BAR; }
    }
    PG8_WAIT_V(0);
    if constexpr (!ALIGN_EPI) { if (wr == 0) PG8_BAR; }
    PG8_BAR;
    if constexpr (Epi::AFTER_DRAIN) { E.fused(acc, cur, wr, wc, fr, fq, lds, wid, lane); S.done(cur); }
#undef PG8_SA
#undef PG8_SB
#undef PG8_STAGE
#undef PG8_LDA
#undef PG8_LDB
#undef PG8_MMA
#undef PG8_WAIT_V
#undef PG8_WAIT_L
#undef PG8_BAR
#undef PG8_SCHED
}
}
#include <hip/hip_cooperative_groups.h>
namespace cg = cooperative_groups;
#define LAS __attribute__((address_space(3)))
typedef unsigned short bf16_t;
typedef short bf16x8 __attribute__((ext_vector_type(8)));
typedef float f32x4 __attribute__((ext_vector_type(4)));
typedef unsigned u32x4 __attribute__((ext_vector_type(4)));
typedef unsigned u32x2 __attribute__((ext_vector_type(2)));

constexpr int NB = 8, T = 4096, D = 1024, M = NB * T, FF = 4096, DEPTH = 4;
constexpr int EV_IN = 2816, OD_IN = 3088, OD_INP = 3328, OD_LD = 3328;
constexpr float EPS = 1e-6f;
constexpr int NTHREADS = 512, NWAVES = 8;
constexpr int LDS_BYTES = 147456;

constexpr size_t MiB = 1u << 20;
constexpr size_t WS_EVIN = 0;
constexpr size_t WS_ODIN = 11 * MiB;
constexpr size_t WS_UP = 24 * MiB;
constexpr size_t WS_DN = 56 * MiB;
constexpr size_t WS_EVOUT = 88 * MiB;
constexpr size_t WS_ODOUT = 92 * MiB;
constexpr size_t WS_ROT = 96 * MiB;
constexpr size_t WS_U = 98 * MiB;
constexpr size_t WS_MIX = 162 * MiB;
constexpr size_t WS_Z = 226 * MiB;
constexpr size_t WS_ST = 434 * MiB;
constexpr size_t WS_DEC = 498 * MiB;
constexpr size_t WS_CTL = 499 * MiB;
constexpr size_t WS_END = 500 * MiB;

struct Params {
    const float* x; const float* norm_g; const float* w_up; const float* w_down; const float* ev_w_in; const float* ev_ret_norm_g; const float* ev_sinks;
    const float* ev_w_out; const float* od_w_in; const float* od_w_gate_up; const float* od_gate_bias; const float* od_norm_g; const float* od_w_out;
    float* out; unsigned char* ws;
    int s_lo, s_hi;
};

__device__ __forceinline__ float wave_sum(float v) {
#pragma unroll
    for (int o = 1; o < 64; o <<= 1) v += __shfl_xor(v, o);
    return v;
}
__device__ __forceinline__ float lo_bf(unsigned w) { return __uint_as_float(w << 16); }
__device__ __forceinline__ float hi_bf(unsigned w) { return __uint_as_float(w & 0xffff0000u); }
__device__ __forceinline__ unsigned pk2(float lo, float hi) { return pg8::cvt_pk_bf16(lo, hi); }
__device__ __forceinline__ unsigned short f2bf(float f) { return (unsigned short)(pg8::cvt_pk_bf16(f, 0.f) & 0xffffu); }
__device__ __forceinline__ void unpack8(const u32x4 v, float (&f)[8]) {
    f[0] = lo_bf(v.x); f[1] = hi_bf(v.x); f[2] = lo_bf(v.y); f[3] = hi_bf(v.y); f[4] = lo_bf(v.z); f[5] = hi_bf(v.z); f[6] = lo_bf(v.w); f[7] = hi_bf(v.w);
}
__device__ __forceinline__ u32x4 pack8(const float (&f)[8]) { u32x4 w; w.x = pk2(f[0], f[1]); w.y = pk2(f[2], f[3]); w.z = pk2(f[4], f[5]); w.w = pk2(f[6], f[7]); return w; }
#define LDS_WAIT() asm volatile("s_waitcnt lgkmcnt(0)" ::: "memory")
#define MFMA16(b, a, c) __builtin_amdgcn_mfma_f32_16x16x32_bf16((b), (a), (c), 0, 0, 0)

__device__ __forceinline__ void transpose_item(const float* W, int K, int N, bf16_t* WT, LAS float* scr, int item, int nblk, int lane) {
    const int kb = item / nblk, nb = item % nblk, k0 = 64 * kb, n0 = 32 * nb;
    const int nn = n0 + (lane & 31); const bool ok = nn < N;
    float v[32];
    const float* wp = W + (size_t)(k0 + (lane >> 5)) * N + (ok ? nn : 0);
#pragma unroll
    for (int i = 0; i < 32; ++i) v[i] = wp[(size_t)(2 * i) * N];
#pragma unroll
    for (int i = 0; i < 32; ++i) { const int kk = 2 * i + (lane >> 5); scr[kk * 33 + (lane & 31)] = ok ? v[i] : 0.f; }
    LDS_WAIT();
    const int c = lane & 7;
#pragma unroll
    for (int j = 0; j < 4; ++j) { const int n = (lane >> 3) + 8 * j; const LAS float* s = scr + (8 * c) * 33 + n;
        u32x4 o; o.x = pk2(s[0 * 33], s[1 * 33]); o.y = pk2(s[2 * 33], s[3 * 33]); o.z = pk2(s[4 * 33], s[5 * 33]); o.w = pk2(s[6 * 33], s[7 * 33]);
        *(u32x4*)(WT + (size_t)(n0 + n) * K + k0 + 8 * c) = o; }
    LDS_WAIT();
}
__device__ __forceinline__ void mat_desc(const Params& p, int mi, const float*& W, int& K, int& N, int& NP, bf16_t*& WT) {
    unsigned char* ws = p.ws;
    if (mi < 2) { W = p.ev_w_in + (size_t)mi * 1024 * EV_IN; K = 1024; N = EV_IN; NP = EV_IN; WT = (bf16_t*)(ws + WS_EVIN) + (size_t)mi * EV_IN * 1024; }
    else if (mi < 4) { const int i = mi - 2; W = p.od_w_in + (size_t)i * 1024 * OD_IN; K = 1024; N = OD_IN; NP = OD_INP; WT = (bf16_t*)(ws + WS_ODIN) + (size_t)i * OD_INP * 1024; }
    else if (mi < 8) { const int l = mi - 4; W = p.w_up + (size_t)l * 1024 * FF; K = 1024; N = FF; NP = FF; WT = (bf16_t*)(ws + WS_UP) + (size_t)l * FF * 1024; }
    else if (mi < 12) { const int l = mi - 8; W = p.w_down + (size_t)l * FF * 1024; K = FF; N = 1024; NP = 1024; WT = (bf16_t*)(ws + WS_DN) + (size_t)l * 1024 * FF; }
    else if (mi < 14) { const int i = mi - 12; W = p.ev_w_out + (size_t)i * 1024 * 1024; K = 1024; N = 1024; NP = 1024; WT = (bf16_t*)(ws + WS_EVOUT) + (size_t)i * 1024 * 1024; }
    else { const int i = mi - 14; W = p.od_w_out + (size_t)i * 1024 * 1024; K = 1024; N = 1024; NP = 1024; WT = (bf16_t*)(ws + WS_ODOUT) + (size_t)i * 1024 * 1024; }
}

__device__ __forceinline__ void norm_phase(const float* Y, const float* Y1, const float* hin, float* hout, const float* g_post, const float* g_pre, bf16_t* U, int gw, int NGW, int lane, float* t0 = nullptr, bool t0_final = false) {
    const int bx = gw / NWAVES % 8, lw = (gw / NWAVES / 8) * NWAVES + gw % NWAVES, NLW = NGW / 8;
    constexpr int NR = 4;
    for (int ml = lw; ml < T; ml += NR * NLW) {
        int m[NR];
#pragma unroll
        for (int q = 0; q < NR; ++q) m[q] = bx * T + ml + q * NLW;
        f32x4 h[NR][4], y[NR][4];
#pragma unroll
        for (int q = 0; q < NR; ++q) { const f32x4* hr = (const f32x4*)(hin + (size_t)m[q] * D) + lane;
#pragma unroll
            for (int j = 0; j < 4; ++j) h[q][j] = __builtin_nontemporal_load(&hr[64 * j]);
            if (Y) { typedef _Float16 h4_t __attribute__((ext_vector_type(4))); const h4_t* yr = (const h4_t*)((const unsigned short*)Y + (size_t)m[q] * D) + lane;
#pragma unroll
                for (int j = 0; j < 4; ++j) { const h4_t yh = __builtin_nontemporal_load(&yr[64 * j]); y[q][j] = (f32x4){(float)yh[0], (float)yh[1], (float)yh[2], (float)yh[3]}; } } }
        if (Y) {
            float s[NR];
#pragma unroll
            for (int q = 0; q < NR; ++q) { s[q] = 0.f;
#pragma unroll
                for (int j = 0; j < 4; ++j) s[q] += (y[q][j][0] * y[q][j][0] + y[q][j][1] * y[q][j][1]) + (y[q][j][2] * y[q][j][2] + y[q][j][3] * y[q][j][3]); }

#pragma unroll
            for (int q = 0; q < NR; ++q) s[q] = wave_sum(s[q]);
            const f32x4* gp = (const f32x4*)g_post + lane;
#pragma unroll
            for (int q = 0; q < NR; ++q) { const float r = rsqrtf(s[q] * (1.f / D) + EPS); f32x4* ho = (f32x4*)(hout + (size_t)m[q] * D) + lane;
#pragma unroll
                for (int j = 0; j < 4; ++j) { h[q][j] = h[q][j] + y[q][j] * r * gp[64 * j]; __builtin_nontemporal_store(h[q][j], &ho[64 * j]); } }
        }
        if (g_pre) {
            float s[NR];
#pragma unroll
            for (int q = 0; q < NR; ++q) { s[q] = 0.f;
#pragma unroll
                for (int j = 0; j < 4; ++j) s[q] += (h[q][j][0] * h[q][j][0] + h[q][j][1] * h[q][j][1]) + (h[q][j][2] * h[q][j][2] + h[q][j][3] * h[q][j][3]); }

#pragma unroll
            for (int q = 0; q < NR; ++q) s[q] = wave_sum(s[q]);
            const f32x4* gp = (const f32x4*)g_pre + lane;
#pragma unroll
            for (int q = 0; q < NR; ++q) { const float r = rsqrtf(s[q] * (1.f / D) + EPS); u32x2* uo = (u32x2*)(U + (size_t)m[q] * D) + lane;
#pragma unroll
                for (int j = 0; j < 4; ++j) { const f32x4 v = h[q][j] * r * gp[64 * j]; u32x2 w; w.x = pk2(v[0], v[1]); w.y = pk2(v[2], v[3]); uo[64 * j] = w; } }
        }
    }
    if (t0 && lw == 0) {
        constexpr int T0_H_ = 0, T0_U_ = 8192, T0_Y_ = 57344;
        f32x4* hr = (f32x4*)(t0 + T0_H_ + bx * 1024) + lane; const f32x4* yr = (const f32x4*)(t0 + T0_Y_ + bx * 1024) + lane;
        f32x4 h[4], y[4]; float s = 0.f;
#pragma unroll
        for (int j = 0; j < 4; ++j) { h[j] = hr[64 * j]; y[j] = yr[64 * j]; s += (y[j][0] * y[j][0] + y[j][1] * y[j][1]) + (y[j][2] * y[j][2] + y[j][3] * y[j][3]); }
        const float r = rsqrtf(wave_sum(s) * (1.f / D) + EPS); const f32x4* gp = (const f32x4*)g_post + lane;
#pragma unroll
        for (int j = 0; j < 4; ++j) { h[j] = h[j] + y[j] * r * gp[64 * j]; hr[64 * j] = h[j]; }
        if (t0_final) { f32x4* ho = (f32x4*)(hout + (size_t)bx * T * D) + lane;
#pragma unroll
            for (int j = 0; j < 4; ++j) ho[64 * j] = h[j]; }
        if (g_pre) { float s2 = 0.f;
#pragma unroll
            for (int j = 0; j < 4; ++j) s2 += (h[j][0] * h[j][0] + h[j][1] * h[j][1]) + (h[j][2] * h[j][2] + h[j][3] * h[j][3]);
            const float r2 = rsqrtf(wave_sum(s2) * (1.f / D) + EPS); const f32x4* gq = (const f32x4*)g_pre + lane; f32x4* ur = (f32x4*)(t0 + T0_U_ + bx * 1024) + lane;
#pragma unroll
            for (int j = 0; j < 4; ++j) ur[64 * j] = h[j] * r2 * gq[64 * j]; }
    }
}
__device__ __forceinline__ void prologue_phase(const Params& p, LAS unsigned char* lds, int tid, int wave, int lane) {
    const int G = gridDim.x, gw = blockIdx.x * NWAVES + wave, NGW = G * NWAVES;
    LAS float* scr = (LAS float*)(lds + wave * 16384);
    constexpr int NITEMS = 2 * 16 * 88 + 2 * 16 * 104 + 4 * 16 * 128 + 4 * 64 * 32 + 4 * 16 * 32;
    for (int it = gw; it < NITEMS; it += NGW) {
        int r = it, mi = 0;
        for (; mi < 16; ++mi) { const int cnt = mi < 2 ? 16 * 88 : mi < 4 ? 16 * 104 : mi < 8 ? 16 * 128 : mi < 12 ? 64 * 32 : 16 * 32; if (r < cnt) break; r -= cnt; }
        const float* W; int K, N, NP; bf16_t* WT; mat_desc(p, mi, W, K, N, NP, WT);
        transpose_item(W, K, N, WT, scr, r, NP / 32, lane);
    }
    float* cosT = (float*)(p.ws + WS_ROT); float* sinT = cosT + T * 64;
    for (int idx = blockIdx.x * NTHREADS + tid; idx < T * 64; idx += G * NTHREADS) {
        const int pos = idx >> 6, i = idx & 63;
        const float invf = (float)exp(-(double)i * (9.210340371976184 / 64.0));
        const float angf = (float)pos * invf;
        double rv = (double)angf * 0.15915494309189535; rv -= floor(rv);
        const float rf = (float)rv;
        cosT[idx] = __builtin_amdgcn_cosf(rf); sinT[idx] = __builtin_amdgcn_sinf(rf);
    }
    norm_phase(nullptr, nullptr, p.x, nullptr, nullptr, p.norm_g, (bf16_t*)(p.ws + WS_U), gw, NGW, lane);
}

constexpr int SW_KS = 72, SW_VS = 280, SW_PS = 168;
constexpr int SW_K_OFF = 0, SW_V_OFF = 272 * SW_KS * 2, SW_P_OFF = SW_V_OFF + 64 * SW_VS * 2;
static_assert(SW_P_OFF + 8 * 16 * SW_PS * 2 <= LDS_BYTES, "swa lds");
__device__ __forceinline__ void swa_unit(LAS unsigned char* lds, const bf16_t* Z, bf16_t* MIX, const float* sinks, int b, int kvh, int n, int tid, int w, int lane) {
    LAS bf16_t* Ks = (LAS bf16_t*)(lds + SW_K_OFF); LAS bf16_t* VTs = (LAS bf16_t*)(lds + SW_V_OFF); LAS bf16_t* Pw = (LAS bf16_t*)(lds + SW_P_OFF) + w * 16 * SW_PS;
    const int fr = lane & 15, fq = lane >> 4;
    const size_t rowb = (size_t)b * T;
    for (int idx = tid; idx < 272 * 8; idx += NTHREADS) { const int jj = idx >> 3, c = idx & 7; const int t = n * 128 - 128 + jj;
        u32x4 v = (u32x4){0u, 0u, 0u, 0u};
        if (jj < 256 && t >= 0) v = *(const u32x4*)(Z + (rowb + t) * EV_IN + 2560 + kvh * 64 + c * 8);
        *(LAS u32x4*)(Ks + jj * SW_KS + c * 8) = v; }
    { const int jj = tid & 255, eh = tid >> 8; const int t = n * 128 - 128 + jj;
#pragma unroll
        for (int c = 0; c < 4; ++c) { u32x4 v = (u32x4){0u, 0u, 0u, 0u};
            if (t >= 0) v = *(const u32x4*)(Z + (rowb + t) * EV_IN + 2688 + kvh * 64 + eh * 32 + c * 8);
            LAS bf16_t* dst = VTs + (eh * 32 + c * 8) * SW_VS + jj;
            dst[0 * SW_VS] = (bf16_t)(v.x & 0xffffu); dst[1 * SW_VS] = (bf16_t)(v.x >> 16); dst[2 * SW_VS] = (bf16_t)(v.y & 0xffffu); dst[3 * SW_VS] = (bf16_t)(v.y >> 16);
            dst[4 * SW_VS] = (bf16_t)(v.z & 0xffffu); dst[5 * SW_VS] = (bf16_t)(v.z >> 16); dst[6 * SW_VS] = (bf16_t)(v.w & 0xffffu); dst[7 * SW_VS] = (bf16_t)(v.w >> 16); } }
    for (int idx = tid; idx < 64 * 24; idx += NTHREADS) VTs[(idx / 24) * SW_VS + 256 + (idx % 24)] = 0;
    __syncthreads();
    const int i = 16 * w + fr; const size_t qrow = rowb + n * 128 + i;
#pragma unroll 1
    for (int g = 0; g < 4; ++g) {
        const int hq = kvh * 4 + g; const float sink = sinks[hq];
        bf16x8 aq[2];
#pragma unroll
        for (int ks = 0; ks < 2; ++ks) aq[ks] = *(const bf16x8*)(Z + qrow * EV_IN + 2048 + hq * 64 + ks * 32 + 8 * fq);
        f32x4 s[10];
#pragma unroll
        for (int nt = 0; nt < 10; ++nt) { s[nt] = (f32x4){0.f, 0.f, 0.f, 0.f};
#pragma unroll
            for (int ks = 0; ks < 2; ++ks) { const bf16x8 bk = *(const LAS bf16x8*)(Ks + (16 * (w + nt) + fr) * SW_KS + ks * 32 + 8 * fq); s[nt] = MFMA16(bk, aq[ks], s[nt]); } }
        float mx = sink;
#pragma unroll
        for (int nt = 0; nt < 10; ++nt)
#pragma unroll
            for (int c = 0; c < 4; ++c) { const int jj = 16 * (w + nt) + 4 * fq + c; const bool ok = (jj > i) && (jj <= i + 128) && (n > 0 || jj >= 128);
                const float v = ok ? s[nt][c] * 0.125f : -1e30f; s[nt][c] = v; mx = fmaxf(mx, v); }
        mx = fmaxf(mx, __shfl_xor(mx, 16)); mx = fmaxf(mx, __shfl_xor(mx, 32));
        float sum = 0.f;
#pragma unroll
        for (int nt = 0; nt < 10; ++nt) {
#pragma unroll
            for (int c = 0; c < 4; ++c) { const float pv = __expf(s[nt][c] - mx); s[nt][c] = pv; sum += pv; }
            u32x2 wv; wv.x = pk2(s[nt][0], s[nt][1]); wv.y = pk2(s[nt][2], s[nt][3]);
            *(LAS u32x2*)(Pw + fr * SW_PS + 16 * nt + 4 * fq) = wv; }
        sum += __shfl_xor(sum, 16); sum += __shfl_xor(sum, 32);
        sum += __expf(sink - mx);
        LDS_WAIT();
        f32x4 o[4];
#pragma unroll
        for (int nt = 0; nt < 4; ++nt) o[nt] = (f32x4){0.f, 0.f, 0.f, 0.f};
#pragma unroll
        for (int ks = 0; ks < 5; ++ks) { const bf16x8 ap = *(const LAS bf16x8*)(Pw + fr * SW_PS + ks * 32 + 8 * fq);
#pragma unroll
            for (int nt = 0; nt < 4; ++nt) { const bf16x8 bv = *(const LAS bf16x8*)(VTs + (16 * nt + fr) * SW_VS + 16 * w + ks * 32 + 8 * fq); o[nt] = MFMA16(bv, ap, o[nt]); } }
        LDS_WAIT();
        const float inv = 1.f / sum;
#pragma unroll
        for (int nt = 0; nt < 4; ++nt) { u32x2 wv; wv.x = pk2(o[nt][0] * inv, o[nt][1] * inv); wv.y = pk2(o[nt][2] * inv, o[nt][3] * inv);
            *(u32x2*)(MIX + qrow * D + 512 + hq * 64 + 16 * nt + 4 * fq) = wv; }
    }
    __syncthreads();
}

constexpr int LA_S = 136;
constexpr int LA_R0 = 0, LA_R1 = 128 * LA_S * 2, LA_X = 2 * 128 * LA_S * 2;
static_assert(LA_X + 256 * LA_S * 2 <= LDS_BYTES && 128 * 129 * 4 <= 256 * LA_S * 2, "la lds");

template <bool GLA> struct LaC { static constexpr int DV = GLA ? 256 : 128, LD = GLA ? OD_LD : EV_IN, GOFF = GLA ? 2048 : 1536; };

__device__ __forceinline__ void gla_compute_b(LAS unsigned char* lds, int xoff, const bf16_t* Z, size_t row0, int h, const float* Wg, const float* bias, int tid) {
    LAS float* Xb = (LAS float*)(lds + xoff); LAS float* al = (LAS float*)(lds + LA_R0); LAS float* tot = al + 128 * 16;
#ifdef DBG_NOB
    { const int d = tid & 127, jq = tid >> 7; for (int jj = 0; jj < 32; ++jj) { const int j = jq * 32 + jj; Xb[j * 129 + d] = -0.05f * (float)(j + 1) * (1.f + (float)d * (1.f / 128.f)); } __syncthreads(); return; }
#endif
    if (tid < 256) { const int j = tid >> 1, c = tid & 1; const u32x4 v = *(const u32x4*)(Z + (row0 + j) * OD_LD + 3072 + c * 8); float f[8]; unpack8(v, f);
        *(LAS f32x4*)(al + j * 16 + c * 8) = (f32x4){f[0], f[1], f[2], f[3]}; *(LAS f32x4*)(al + j * 16 + c * 8 + 4) = (f32x4){f[4], f[5], f[6], f[7]}; }
    __syncthreads();
    const int d = tid & 127, jq = tid >> 7;
    float wg[16];
#pragma unroll
    for (int r = 0; r < 16; ++r) wg[r] = Wg[r * 512 + h * 128 + d];
    const float bs = bias[h * 128 + d];
    float s = 0.f;
#pragma unroll 4
    for (int jj = 0; jj < 32; ++jj) { const int j = jq * 32 + jj; float x = bs;
#pragma unroll
        for (int r4 = 0; r4 < 4; ++r4) { const f32x4 a = *(const LAS f32x4*)(al + j * 16 + r4 * 4); x += a[0] * wg[r4 * 4 + 0] + a[1] * wg[r4 * 4 + 1] + a[2] * wg[r4 * 4 + 2] + a[3] * wg[r4 * 4 + 3]; }
        const float lg = (fminf(x, 0.f) - __logf(1.f + __expf(-fabsf(x)))) * (1.f / 16.f);
        s += lg; Xb[j * 129 + d] = s; }
    tot[jq * 128 + d] = s;
    __syncthreads();
    float off = 0.f;
#pragma unroll
    for (int q = 0; q < 3; ++q) if (q < jq) off += tot[q * 128 + d];
    if (jq > 0) {
#pragma unroll 4
        for (int jj = 0; jj < 32; ++jj) Xb[(jq * 32 + jj) * 129 + d] += off; }
    __syncthreads();
}

template <bool ROT> __device__ __forceinline__ void load_rot8(const bf16_t* src, const float* cosr, const float* sinr, float (&r1)[8], float (&r2)[8]) {
    const u32x4 a = *(const u32x4*)src, b = *(const u32x4*)(src + 64); unpack8(a, r1); unpack8(b, r2);
    if (ROT) { const f32x4 c0 = *(const f32x4*)cosr, c1 = *(const f32x4*)(cosr + 4), s0 = *(const f32x4*)sinr, s1 = *(const f32x4*)(sinr + 4);
#pragma unroll
        for (int e = 0; e < 8; ++e) { const float cs = e < 4 ? c0[e & 3] : c1[e & 3], sn = e < 4 ? s0[e & 3] : s1[e & 3]; const float t1 = r1[e] * cs - r2[e] * sn, t2 = r1[e] * sn + r2[e] * cs; r1[e] = t1; r2[e] = t2; } }
}

template <bool GLA, int NR> __device__ __forceinline__ void la_stage_vt(LAS unsigned char* lds, int xoff, const bf16_t* Z, size_t row0, int h, int e0, int tid) {
    constexpr int DV = LaC<GLA>::DV, LD = LaC<GLA>::LD;
    LAS bf16_t* VT = (LAS bf16_t*)(lds + xoff);
    const int j = tid & 127, eq = tid >> 7; const bf16_t* vrow = Z + (row0 + j) * LD + 1024 + h * DV + e0 + eq * (NR / 4);
#pragma unroll
    for (int c = 0; c < NR / 32; ++c) { const u32x4 v = *(const u32x4*)(vrow + c * 8); LAS bf16_t* dst = VT + (eq * (NR / 4) + c * 8) * LA_S + j;
        dst[0 * LA_S] = (bf16_t)(v.x & 0xffffu); dst[1 * LA_S] = (bf16_t)(v.x >> 16); dst[2 * LA_S] = (bf16_t)(v.y & 0xffffu); dst[3 * LA_S] = (bf16_t)(v.y >> 16);
        dst[4 * LA_S] = (bf16_t)(v.z & 0xffffu); dst[5 * LA_S] = (bf16_t)(v.z >> 16); dst[6 * LA_S] = (bf16_t)(v.w & 0xffffu); dst[7 * LA_S] = (bf16_t)(v.w >> 16); }
}

template <bool GLA> __device__ __forceinline__ void la1_unit(LAS unsigned char* lds, const Params& p, int li, int u, int half, int tid, int w, int lane) {
    constexpr int DV = LaC<GLA>::DV, LD = LaC<GLA>::LD, MT = DV / 128;
    const bf16_t* Z = (const bf16_t*)(p.ws + WS_Z); bf16_t* ST = (bf16_t*)(p.ws + WS_ST); float* DEC = (float*)(p.ws + WS_DEC);
    const float* cosT = (const float*)(p.ws + WS_ROT); const float* sinT = cosT + T * 64;
    const int b = u >> 7, h = (u >> 5) & 3, n = u & 31; const size_t row0 = (size_t)b * T + n * 128;
    const int fr = lane & 15, fq = lane >> 4;
    constexpr int LA1X = LA_R1;
    LAS bf16_t* KdT = (LAS bf16_t*)(lds + LA_R0); LAS float* Xb = (LAS float*)(lds + LA1X); LAS bf16_t* VT = (LAS bf16_t*)(lds + LA1X);
    if (GLA) gla_compute_b(lds, LA1X, Z, row0, h, p.od_w_gate_up + (size_t)li * 16 * 512, p.od_gate_bias + li * 512, tid);
    const float lgam = GLA ? 0.f : log1pf(-exp2f(-5.f - (float)h));
    {   const int j = tid & 127, pq = tid >> 7, pos = n * 128 + j; const bf16_t* krow = Z + (row0 + j) * LD + 512 + h * 128;
#pragma unroll
        for (int c = 0; c < 2; ++c) { const int i0 = pq * 16 + c * 8; float r1[8], r2[8];
#ifdef DBG_NOROT
            load_rot8<false>(krow + i0, cosT + pos * 64 + i0, sinT + pos * 64 + i0, r1, r2);
#else
            load_rot8<!GLA>(krow + i0, cosT + pos * 64 + i0, sinT + pos * 64 + i0, r1, r2);
#endif
#pragma unroll
            for (int e = 0; e < 8; ++e) { const int d1 = i0 + e, d2 = d1 + 64; float f1, f2;
                if (GLA) { f1 = __expf(Xb[127 * 129 + d1] - Xb[j * 129 + d1]); f2 = __expf(Xb[127 * 129 + d2] - Xb[j * 129 + d2]); } else { f1 = f2 = __expf(lgam * (float)(127 - j)); }
                KdT[d1 * LA_S + j] = f2bf(r1[e] * f1); KdT[d2 * LA_S + j] = f2bf(r2[e] * f2); } }
#ifndef DBG_NODEC
        if (GLA && w < 2 && half == 0) DEC[(size_t)u * 128 + (tid & 127)] = __expf(Xb[127 * 129 + (tid & 127)]);
#endif
    }
    __syncthreads();
    la_stage_vt<GLA, DV>(lds, LA1X, Z, row0, h, 0, tid);
    __syncthreads();
    f32x4 acc[MT][8];
#pragma unroll
    for (int mt = 0; mt < MT; ++mt)
#pragma unroll
        for (int nt = 0; nt < 8; ++nt) acc[mt][nt] = (f32x4){0.f, 0.f, 0.f, 0.f};
#pragma unroll
    for (int ks = 0; ks < 4; ++ks) { bf16x8 a[MT];
#pragma unroll
        for (int mt = 0; mt < MT; ++mt) a[mt] = *(const LAS bf16x8*)(VT + (w * 16 * MT + 16 * mt + fr) * LA_S + ks * 32 + 8 * fq);
#pragma unroll
        for (int nt = 0; nt < 8; ++nt) { bf16x8 bb = *(const LAS bf16x8*)(KdT + (16 * nt + fr) * LA_S + ks * 32 + 8 * fq);
#ifdef DBG_ONEK
            bb = (bf16x8){0x3f80, 0x3f80, 0x3f80, 0x3f80, 0x3f80, 0x3f80, 0x3f80, 0x3f80};
#endif
#ifdef DBG_ONEV
            a[0] = (bf16x8){0x3f80, 0x3f80, 0x3f80, 0x3f80, 0x3f80, 0x3f80, 0x3f80, 0x3f80};
#endif
#pragma unroll
            for (int mt = 0; mt < MT; ++mt) acc[mt][nt] = MFMA16(bb, a[mt], acc[mt][nt]); } }
    bf16_t* stu = ST + (size_t)u * DV * 128 + (size_t)half * 128 * 128;
#pragma unroll
    for (int mt = 0; mt < MT; ++mt)
#pragma unroll
        for (int nt = 0; nt < 8; ++nt) { u32x2 wv; wv.x = pk2(acc[mt][nt][0], acc[mt][nt][1]); wv.y = pk2(acc[mt][nt][2], acc[mt][nt][3]);
#ifdef DBG_CONSTST
            wv.x = pk2((float)(u & 63), (float)nt); wv.y = pk2((float)fr, (float)fq);
#endif
            *(u32x2*)(stu + (size_t)(w * 16 * MT + 16 * mt + fr) * 128 + 16 * nt + 4 * fq) = wv; }
    __syncthreads();
}

template <bool GLA> __device__ __forceinline__ void la2_phase(const Params& p, int tid, int bx, int rk, int NL) {
    constexpr int DV = LaC<GLA>::DV;
    bf16_t* ST = (bf16_t*)(p.ws + WS_ST); const float* DEC = (const float*)(p.ws + WS_DEC);
    const int totl = 4 * DV * 16;
    for (int itl = rk * NTHREADS + tid; itl < totl; itl += NL * NTHREADS) { const int it = bx * totl + itl;
        const int dg = it & 15, e = (it >> 4) % DV, bh = it / (16 * DV);
        const float cdec = GLA ? 0.f : __expf(128.f * log1pf(-exp2f(-5.f - (float)(bh & 3))));
        float S[8];
#pragma unroll
        for (int k = 0; k < 8; ++k) S[k] = 0.f;
#pragma unroll 4
        for (int n = 0; n < 32; ++n) { const size_t u = (size_t)bh * 32 + n; u32x4* ptr = (u32x4*)(ST + (u * DV + e) * 128 + dg * 8);
            const u32x4 kvw = *ptr; float kv[8]; unpack8(kvw, kv);
            float dc[8];
            if (GLA) { const f32x4 d0 = *(const f32x4*)(DEC + u * 128 + dg * 8), d1 = *(const f32x4*)(DEC + u * 128 + dg * 8 + 4);
                dc[0] = d0[0]; dc[1] = d0[1]; dc[2] = d0[2]; dc[3] = d0[3]; dc[4] = d1[0]; dc[5] = d1[1]; dc[6] = d1[2]; dc[7] = d1[3]; }
            else {
#pragma unroll
                for (int k = 0; k < 8; ++k) dc[k] = cdec; }
            *ptr = pack8(S);
#pragma unroll
            for (int k = 0; k < 8; ++k) S[k] = dc[k] * S[k] + kv[k]; }
    }
}

template <bool GLA> __device__ __forceinline__ void la3_unit(LAS unsigned char* lds, const Params& p, int li, int u, int tid, int w, int lane) {
    constexpr int DV = LaC<GLA>::DV, LD = LaC<GLA>::LD, GOFF = LaC<GLA>::GOFF, NT = DV / 16;
    const bf16_t* Z = (const bf16_t*)(p.ws + WS_Z); const bf16_t* ST = (const bf16_t*)(p.ws + WS_ST); bf16_t* MIX = (bf16_t*)(p.ws + WS_MIX);
    const float* cosT = (const float*)(p.ws + WS_ROT); const float* sinT = cosT + T * 64;
    const float* ng = GLA ? p.od_norm_g + li * 1024 : p.ev_ret_norm_g + li * 512;
    const int b = u >> 7, h = (u >> 5) & 3, n = u & 31; const size_t row0 = (size_t)b * T + n * 128;
    const int fr = lane & 15, fq = lane >> 4;
    LAS bf16_t* Qin = (LAS bf16_t*)(lds + LA_R0); LAS bf16_t* Kin = (LAS bf16_t*)(lds + LA_R1); LAS float* Xb = (LAS float*)(lds + LA_X); LAS bf16_t* Xs = (LAS bf16_t*)(lds + LA_X);
    if (GLA) gla_compute_b(lds, LA_X, Z, row0, h, p.od_w_gate_up + (size_t)li * 16 * 512, p.od_gate_bias + li * 512, tid);
    const float lgam = GLA ? 0.f : log1pf(-exp2f(-5.f - (float)h));
    const float scale = 0.08838834764831845f;
    {   const int j = tid >> 2, pq = tid & 3, pos = n * 128 + j; const bf16_t* qrow = Z + (row0 + j) * LD + h * 128; const bf16_t* krow = qrow + 512;
#pragma unroll
        for (int c = 0; c < 2; ++c) { const int i0 = pq * 8 + c * 32; float q1[8], q2[8], k1[8], k2[8];
            load_rot8<!GLA>(qrow + i0, cosT + pos * 64 + i0, sinT + pos * 64 + i0, q1, q2);
            load_rot8<!GLA>(krow + i0, cosT + pos * 64 + i0, sinT + pos * 64 + i0, k1, k2);
#pragma unroll
            for (int e = 0; e < 8; ++e) { float b1, b2;
                if (GLA) { b1 = Xb[j * 129 + i0 + e]; b2 = Xb[j * 129 + 64 + i0 + e]; } else { b1 = b2 = lgam * (float)(j + 1); }
                q1[e] *= scale * __expf(b1); q2[e] *= scale * __expf(b2); k1[e] *= __expf(-b1); k2[e] *= __expf(-b2); }
            *(LAS u32x4*)(Qin + j * LA_S + i0) = pack8(q1); *(LAS u32x4*)(Qin + j * LA_S + 64 + i0) = pack8(q2);
            *(LAS u32x4*)(Kin + j * LA_S + i0) = pack8(k1); *(LAS u32x4*)(Kin + j * LA_S + 64 + i0) = pack8(k2); }
    }
    __syncthreads();
    {   const bf16_t* stu = ST + (size_t)u * DV * 128;
        for (int idx = tid; idx < DV * 16; idx += NTHREADS) { const int e = idx >> 4, c = idx & 15; *(LAS u32x4*)(Xs + e * LA_S + c * 8) = *(const u32x4*)(stu + (size_t)e * 128 + c * 8); } }
    __syncthreads();
    f32x4 acco[NT], accA[8];
#pragma unroll
    for (int nt = 0; nt < NT; ++nt) acco[nt] = (f32x4){0.f, 0.f, 0.f, 0.f};
#pragma unroll
    for (int nt = 0; nt < 8; ++nt) accA[nt] = (f32x4){0.f, 0.f, 0.f, 0.f};
#pragma unroll
    for (int ks = 0; ks < 4; ++ks) { const bf16x8 a = *(const LAS bf16x8*)(Qin + (16 * w + fr) * LA_S + ks * 32 + 8 * fq);
#pragma unroll
        for (int nt = 0; nt < NT; ++nt) { const bf16x8 bb = *(const LAS bf16x8*)(Xs + (16 * nt + fr) * LA_S + ks * 32 + 8 * fq); acco[nt] = MFMA16(bb, a, acco[nt]); }
#pragma unroll
        for (int nt = 0; nt < 8; ++nt) if (nt <= w) { const bf16x8 bb = *(const LAS bf16x8*)(Kin + (16 * nt + fr) * LA_S + ks * 32 + 8 * fq); accA[nt] = MFMA16(bb, a, accA[nt]); } }
    {   const int i = 16 * w + fr;
#pragma unroll
        for (int nt = 0; nt < 8; ++nt)
#pragma unroll
            for (int c = 0; c < 4; ++c) { const int j = 16 * nt + 4 * fq + c; if (j > i) accA[nt][c] = 0.f; } }
    __syncthreads();
#pragma unroll
    for (int nt = 0; nt < 8; ++nt) { u32x2 wv; wv.x = pk2(accA[nt][0], accA[nt][1]); wv.y = pk2(accA[nt][2], accA[nt][3]); *(LAS u32x2*)(Qin + (16 * w + fr) * LA_S + 16 * nt + 4 * fq) = wv; }
    la_stage_vt<GLA, LaC<GLA>::DV>(lds, LA_X, Z, row0, h, 0, tid);
    __syncthreads();
#pragma unroll
    for (int ks = 0; ks < 4; ++ks) if (2 * ks <= w) { const bf16x8 a = *(const LAS bf16x8*)(Qin + (16 * w + fr) * LA_S + ks * 32 + 8 * fq);
#pragma unroll
        for (int nt = 0; nt < NT; ++nt) { const bf16x8 bb = *(const LAS bf16x8*)(Xs + (16 * nt + fr) * LA_S + ks * 32 + 8 * fq); acco[nt] = MFMA16(bb, a, acco[nt]); } }
    float ss = 0.f;
#pragma unroll
    for (int nt = 0; nt < NT; ++nt) ss += (acco[nt][0] * acco[nt][0] + acco[nt][1] * acco[nt][1]) + (acco[nt][2] * acco[nt][2] + acco[nt][3] * acco[nt][3]);
    ss += __shfl_xor(ss, 16); ss += __shfl_xor(ss, 32);
    const float r = rsqrtf(ss * (1.f / DV) + EPS);
    const size_t orow = row0 + 16 * w + fr;
#pragma unroll
    for (int nt = 0; nt < NT; ++nt) { const int e = 16 * nt + 4 * fq; const f32x4 g4 = *(const f32x4*)(ng + h * DV + e);
        const u32x2 gw2 = *(const u32x2*)(Z + orow * LD + GOFF + h * DV + e);
        const float g0 = lo_bf(gw2.x), g1 = hi_bf(gw2.x), g2 = lo_bf(gw2.y), g3 = hi_bf(gw2.y);
        const float v0 = acco[nt][0] * r * g4[0] * (g0 / (1.f + __expf(-g0))), v1 = acco[nt][1] * r * g4[1] * (g1 / (1.f + __expf(-g1)));
        const float v2 = acco[nt][2] * r * g4[2] * (g2 / (1.f + __expf(-g2))), v3 = acco[nt][3] * r * g4[3] * (g3 / (1.f + __expf(-g3)));
        u32x2 wv; wv.x = pk2(v0, v1); wv.y = pk2(v2, v3);
        *(u32x2*)(MIX + orow * D + h * DV + e) = wv; }
    __syncthreads();
}

__device__ __forceinline__ float block_sum(float v, LAS float* red, int tid) {
    v = wave_sum(v); __syncthreads(); if ((tid & 63) == 0) red[tid >> 6] = v; __syncthreads();
    float t = 0.f;
#pragma unroll
    for (int i = 0; i < NWAVES; ++i) t += red[i];
    return t;
}
template <bool ADD> __device__ __forceinline__ void t0_rmsnorm_(const LAS float* in, const float* g, LAS float* dst, LAS float* red, int tid) {
    const float a = in[tid], b = in[tid + 512]; const float r = rsqrtf(block_sum(a * a + b * b, red, tid) * (1.f / D) + EPS);
    if (ADD) { dst[tid] += a * r * g[tid]; dst[tid + 512] += b * r * g[tid + 512]; } else { dst[tid] = a * r * g[tid]; dst[tid + 512] = b * r * g[tid + 512]; }
    __syncthreads();
}
__device__ __forceinline__ void t0_gemv(const float* W, int K, int N, const LAS float* in, LAS float* outv, int act, int tid) {
    for (int n = tid; n < N; n += NTHREADS) { float acc[8];
#pragma unroll
        for (int i = 0; i < 8; ++i) acc[i] = 0.f;
        for (int k = 0; k < K; k += 8) {
#pragma unroll
            for (int i = 0; i < 8; ++i) acc[i] += in[k + i] * W[(size_t)(k + i) * N + n]; }
        float a = ((acc[0] + acc[1]) + (acc[2] + acc[3])) + ((acc[4] + acc[5]) + (acc[6] + acc[7]));
        if (act == 2) { a = fmaxf(a, 0.f); a = a * a; }
        outv[n] = a; }
    __syncthreads();
}
constexpr size_t WS_T0 = WS_CTL + 65536;
constexpr int T0_H = 0, T0_U = 8192, T0_Z = 16384, T0_MIX = 49152, T0_Y = 57344;
__device__ __forceinline__ void t0_skinny(const float* W, int K, int N, const float* in, int ldi, float* outp, int ldo, int act, LAS unsigned char* lds, int tid) {
    const int CW = N >= 2048 ? 16 : 4, NKP = NTHREADS / CW, KS = K / NKP;
    const int c = tid % CW, kp = tid / CW, col = blockIdx.x * CW + c;
    if (blockIdx.x * CW >= N) return;
    float acc[8];
#pragma unroll
    for (int r = 0; r < 8; ++r) acc[r] = 0.f;
    if (col < N) {
        for (int k = kp * KS; k < (kp + 1) * KS; k += 4) { float w[4];
#pragma unroll
            for (int i = 0; i < 4; ++i) w[i] = W[(size_t)(k + i) * N + col];
#pragma unroll
            for (int r = 0; r < 8; ++r) { const f32x4 x = *(const f32x4*)(in + (size_t)r * ldi + k); acc[r] += x[0] * w[0] + x[1] * w[1] + x[2] * w[2] + x[3] * w[3]; } } }
#pragma unroll
    for (int r = 0; r < 8; ++r) { float a = acc[r]; for (int o = CW; o < 64; o <<= 1) a += __shfl_xor(a, o); acc[r] = a; }
    LAS float* part = (LAS float*)lds;
    if ((tid & 63) < CW) {
#pragma unroll
        for (int r = 0; r < 8; ++r) part[((tid >> 6) * CW + c) * 8 + r] = acc[r]; }
    __syncthreads();
    if (tid < CW * 8) { const int cc = tid >> 3, r = tid & 7; float a = 0.f;
#pragma unroll
        for (int q = 0; q < NWAVES; ++q) a += part[(q * CW + cc) * 8 + r];
        if (act == 2) { a = fmaxf(a, 0.f); a = a * a; }
        const int n = blockIdx.x * CW + cc; if (n < N) outp[(size_t)r * ldo + n] = a; }
    __syncthreads();
}
__device__ __forceinline__ void t0_load(LAS float* dst, const float* src, int n, int tid) { for (int i = tid; i < n; i += NTHREADS) dst[i] = src[i]; __syncthreads(); }
__device__ __forceinline__ void t0_store(float* dst, const LAS float* src, int n, int tid) { for (int i = tid; i < n; i += NTHREADS) dst[i] = src[i]; __syncthreads(); }

__device__ __forceinline__ void t0_mix_even(const Params& p, int li, const LAS float* z, LAS float* mix, LAS float* sc, int tid) {
            if (tid < 4 * 64) { const int hh = tid >> 6, l = tid & 63; float a = z[hh * 128 + l] * z[512 + hh * 128 + l] + z[hh * 128 + 64 + l] * z[512 + hh * 128 + 64 + l];
                float v2 = z[1024 + hh * 128 + l] * z[1024 + hh * 128 + l] + z[1024 + hh * 128 + 64 + l] * z[1024 + hh * 128 + 64 + l];
                a = wave_sum(a) * 0.08838834764831845f; v2 = wave_sum(v2); if (l == 0) { sc[2 * hh] = a; sc[2 * hh + 1] = a * a * v2 * (1.f / 128.f); } }
            __syncthreads();
            { const int hh = tid >> 7, e = tid; const float sv = sc[2 * hh], r = rsqrtf(sc[2 * hh + 1] + EPS), gt = z[1536 + e];
              mix[e] = sv * z[1024 + e] * r * p.ev_ret_norm_g[li * 512 + e] * (gt / (1.f + expf(-gt))); }
            { const int hq = tid >> 6, l = tid & 63, kv = hq >> 2; float a = wave_sum(z[2048 + hq * 64 + l] * z[2560 + kv * 64 + l]) * 0.125f;
              const float sink = p.ev_sinks[li * 8 + hq], m = fmaxf(a, sink), pe = expf(a - m), den = pe + expf(sink - m);
              mix[512 + hq * 64 + l] = (pe / den) * z[2688 + kv * 64 + l]; }
            __syncthreads();
}
__device__ __forceinline__ void t0_mix_odd(const Params& p, int li, const LAS float* z, LAS float* mix, LAS float* sc, int tid) {
            if (tid < 4 * 64) { const int hh = tid >> 6, l = tid & 63; float a = z[hh * 128 + l] * z[512 + hh * 128 + l] + z[hh * 128 + 64 + l] * z[512 + hh * 128 + 64 + l];
                float v2 = 0.f;
#pragma unroll
                for (int q = 0; q < 4; ++q) { const float vv = z[1024 + hh * 256 + q * 64 + l]; v2 += vv * vv; }
                a = wave_sum(a) * 0.08838834764831845f; v2 = wave_sum(v2); if (l == 0) { sc[2 * hh] = a; sc[2 * hh + 1] = a * a * v2 * (1.f / 256.f); } }
            __syncthreads();
#pragma unroll
            for (int q = 0; q < 2; ++q) { const int e = tid + 512 * q, hh = e >> 8; const float sv = sc[2 * hh], r = rsqrtf(sc[2 * hh + 1] + EPS), gt = z[2048 + e];
                mix[e] = sv * z[1024 + e] * r * p.od_norm_g[li * 1024 + e] * (gt / (1.f + expf(-gt))); }
            __syncthreads();
}
__device__ __forceinline__ void t0_path(const Params& p, LAS unsigned char* lds, int b, int tid, int nlayers = DEPTH) {
    LAS float* h = (LAS float*)lds; LAS float* u = h + 1024; LAS float* z = u + 1024; LAS float* mix = z + 4096; LAS float* y = mix + 1024; LAS float* red = y + 1024; LAS float* sc = red + 16;
    h[tid] = p.x[(size_t)b * T * D + tid]; h[tid + 512] = p.x[(size_t)b * T * D + tid + 512];
    __syncthreads();
#pragma unroll 1
    for (int layer = 0; layer < nlayers; ++layer) { const int li = layer >> 1; const float* ng = p.norm_g + (size_t)layer * 4 * D;
        t0_rmsnorm_<false>(h, ng, u, red, tid);
        if (!(layer & 1)) {
            t0_gemv(p.ev_w_in + (size_t)li * 1024 * EV_IN, 1024, EV_IN, u, z, 0, tid);
            t0_mix_even(p, li, z, mix, sc, tid);
            t0_gemv(p.ev_w_out + (size_t)li * 1024 * 1024, 1024, 1024, mix, y, 0, tid);
        } else {
            t0_gemv(p.od_w_in + (size_t)li * 1024 * OD_IN, 1024, OD_IN, u, z, 0, tid);
            t0_mix_odd(p, li, z, mix, sc, tid);
            t0_gemv(p.od_w_out + (size_t)li * 1024 * 1024, 1024, 1024, mix, y, 0, tid);
        }
        t0_rmsnorm_<true>(y, ng + D, h, red, tid);
        t0_rmsnorm_<false>(h, ng + 2 * D, u, red, tid);
        t0_gemv(p.w_up + (size_t)layer * 1024 * FF, 1024, FF, u, z, 2, tid);
        t0_gemv(p.w_down + (size_t)layer * FF * 1024, FF, 1024, z, y, 0, tid);
        t0_rmsnorm_<true>(y, ng + 3 * D, h, red, tid);
    }
#ifdef DBG_T0CMP
    { const float d0 = fabsf(p.out[(size_t)b * T * D + tid] - h[tid]), d1 = fabsf(p.out[(size_t)b * T * D + tid + 512] - h[tid + 512]);
      if (d0 > DBG_T0CMP || d1 > DBG_T0CMP) p.out[(size_t)b * T * D + tid] = __builtin_nanf(""); }
#else
    p.out[(size_t)b * T * D + tid] = h[tid]; p.out[(size_t)b * T * D + tid + 512] = h[tid + 512];
#endif
}

struct XcdOrder {
    int nN, nu, NL, bx, rk, blk;
    __device__ void init(int N, int G, int c) { nN = N / pg8::BM; nu = 16 * nN; NL = G >> 3; bx = c & 7; rk = c >> 3; blk = (NL == 32) ? 1 : 0; }
    __device__ bool next(int i, pg8::Unit& u) const {
        if (blk) { if (nN == 13 && i >= 6) { if (i > 6 || rk >= 16) return false; u.pm = bx * 16 + rk; u.pn = 12; return true; }
            const int pn = 4 * (i >> 1) + (rk >> 3); if (pn >= nN) return false; u.pm = bx * 16 + 8 * (i & 1) + (rk & 7); u.pn = pn; return true; }
        const int L = i * NL + rk; if (L >= nu) return false; u.pm = bx * 16 + (L & 15); u.pn = L >> 4; return true; }
    __device__ __forceinline__ void a_ready(const pg8::Unit&) const {}
    __device__ __forceinline__ void done(const pg8::Unit&) const {}
};
#ifndef PG8_ALIGN_OPT
#define PG8_ALIGN_OPT true
#endif
#ifndef PG8_SP2_OPT
#define PG8_SP2_OPT true
#endif
#define GAS __attribute__((address_space(1)))
#define XB_TMO      128
#define XB_XCNT(j)  (256  + 64 * (j))
#define XB_XSUB(j)  (1280 + 64 * (j))
#define XB_XGEN(j)  (2304 + 64 * (j))
#define XB_TOP      3328
#define XB_TOPGEN   3392
#define XCD_BAR_WORDS 3456
#define XB_SPIN_CAP (1u << 18)

__device__ __forceinline__ unsigned xb_ld(unsigned* p)              { return __hip_atomic_load(p, __ATOMIC_RELAXED, __HIP_MEMORY_SCOPE_AGENT); }
__device__ __forceinline__ unsigned xb_add(unsigned* p, unsigned v) { return __hip_atomic_fetch_add(p, v, __ATOMIC_RELAXED, __HIP_MEMORY_SCOPE_AGENT); }
__device__ __forceinline__ unsigned xb_xcc_id() { return (unsigned)__builtin_amdgcn_s_getreg((3 << 11) | 20) & 0xFu; }
#define XB_SPIN(cond, bar) do { unsigned _sp = 0; while (cond) { __builtin_amdgcn_s_sleep(1); \
    if ((++_sp & 255u) == 0u) { if (xb_ld(&(bar)[XB_TMO])) break; if (_sp > XB_SPIN_CAP) { atomicAdd(&(bar)[XB_TMO], 1u); break; } } } } while (0)

struct XcdBarrier {
    unsigned* bar; unsigned x;
    volatile LAS unsigned* st;
};

__device__ __forceinline__ XcdBarrier xcd_barrier_post(unsigned* bar, volatile LAS unsigned* st) {
    XcdBarrier b; b.bar = bar; b.x = xb_xcc_id(); b.st = st;
    if (threadIdx.x == 0) (void)xb_add(&bar[XB_XCNT(b.x)], 1u);
    return b;
}
__device__ __forceinline__ void xcd_barrier_complete(unsigned* bar, unsigned x, unsigned& nloc, unsigned& nx) {
    const unsigned G = gridDim.x * gridDim.y * gridDim.z;
    unsigned sum, cnt, mine, sp = 0u;
    for (;;) {
        sum = 0u; cnt = 0u; mine = 0u;
#pragma unroll
        for (unsigned j = 0; j < 16; ++j) { const unsigned c = xb_ld(&bar[XB_XCNT(j)]); sum += c; cnt += (c > 0u) ? 1u : 0u; mine = (j == x) ? c : mine; }
        if (sum == G) break;
        __builtin_amdgcn_s_sleep(1);
        if ((++sp & 255u) == 0u) { if (xb_ld(&bar[XB_TMO])) break; if (sp > XB_SPIN_CAP) { atomicAdd(&bar[XB_TMO], 1u); break; } }
    }
    nloc = mine > 0u ? mine : 1u; nx = cnt > 0u ? cnt : 1u;
}

__device__ __forceinline__ void xcd_barrier(const XcdBarrier& b) {
    asm volatile("s_waitcnt vmcnt(0)" ::: "memory");
    __syncthreads();
    if (threadIdx.x == 0) {
        unsigned* bar = b.bar;
        __builtin_amdgcn_s_waitcnt(0);
        unsigned nloc = b.st[0], nx = b.st[1];
        if (nloc == 0u) { xcd_barrier_complete(bar, b.x, nloc, nx); b.st[0] = nloc; b.st[1] = nx; }
        const unsigned old = xb_add(&bar[XB_XSUB(b.x)], 1u);
        const unsigned gen = old / nloc;
        if (old + 1u == (gen + 1u) * nloc) {
            __builtin_amdgcn_fence(__ATOMIC_RELEASE, "agent");
            asm volatile("s_waitcnt vmcnt(0)" ::: "memory");
            const unsigned og = xb_add(&bar[XB_TOP], 1u);
            const unsigned tg = og / nx;
            if (og + 1u == (tg + 1u) * nx) xb_add(&bar[XB_TOPGEN], 1u);
            else XB_SPIN(xb_ld(&bar[XB_TOPGEN]) == tg, bar);
            __builtin_amdgcn_fence(__ATOMIC_ACQUIRE, "agent");
            xb_add(&bar[XB_XGEN(b.x)], 1u);
            asm volatile("s_waitcnt vmcnt(0)" ::: "memory");
        } else {
            XB_SPIN(xb_ld(&bar[XB_XGEN(b.x)]) == gen, bar);
            __builtin_amdgcn_fence(__ATOMIC_ACQUIRE, "agent");
            asm volatile("s_waitcnt vmcnt(0)" ::: "memory");
        }
    }
    __syncthreads();
}

#define GRID_SYNC() xcd_barrier(xbar)
__global__ void __launch_bounds__(NTHREADS, 2) mega_fwd(Params p) {
    extern __shared__ __attribute__((aligned(16))) unsigned char lds_raw[];
    LAS unsigned char* lds = (LAS unsigned char*)lds_raw;
    cg::grid_group grid = cg::this_grid();
    const int G = gridDim.x;
#ifdef DBG_DELAY_US
#pragma unroll 1
    for (int dly = 0; dly < DBG_DELAY_US / 3; ++dly) __builtin_amdgcn_s_sleep(127);
#endif
    volatile LAS unsigned* xst = (volatile LAS unsigned*)(lds + LDS_BYTES - 16);
    if (threadIdx.x < 2) xst[threadIdx.x] = 0u;
    __syncthreads();
    const XcdBarrier xbar = xcd_barrier_post((unsigned*)(p.ws + WS_CTL), xst);
    if (p.s_lo == 0) {
        {   int tid = threadIdx.x; asm volatile("" : "+v"(tid)); const int lane = tid & 63, wave = __builtin_amdgcn_readfirstlane(tid >> 6);
            prologue_phase(p, lds, tid, wave, lane);
            if (blockIdx.x < NB) {
                __syncthreads(); float* T0 = (float*)(p.ws + WS_T0); const int b = blockIdx.x;
                LAS float* h = (LAS float*)lds; LAS float* u = h + 1024; LAS float* red = h + 8192;
                t0_load(h, p.x + (size_t)b * T * D, 1024, tid); t0_rmsnorm_<false>(h, p.norm_g, u, red, tid);
                t0_store(T0 + T0_H + b * 1024, h, 1024, tid); t0_store(T0 + T0_U + b * 1024, u, 1024, tid); } }
        if (p.s_hi > 1) {
            asm volatile("s_waitcnt vmcnt(0) lgkmcnt(0)" ::: "memory"); __syncthreads();
            grid.sync();
            GRID_SYNC();
        }
    }

#pragma unroll 1
    for (int layer_i = 0; layer_i < DEPTH; ++layer_i) {
#pragma unroll 1
        for (int ph = 0; ph < 9; ++ph) {
            const int step = 1 + layer_i * 9 + ph; if (step < p.s_lo || step >= p.s_hi) continue;
            int layer = layer_i; asm volatile("" : "+s"(layer));
            const int li = layer >> 1; const bool odd = layer & 1;
            int tid = threadIdx.x; asm volatile("" : "+v"(tid)); const int lane = tid & 63, wave = __builtin_amdgcn_readfirstlane(tid >> 6);
            const int gw = blockIdx.x * NWAVES + wave, NGW = G * NWAVES;
            int wv = tid >> 6; asm volatile("" : "+v"(wv));
            const int bx = blockIdx.x & 7, rk = blockIdx.x >> 3, NL = G >> 3;
            unsigned char* ws = p.ws; asm volatile("" : "+s"(ws));
            bf16_t* U = (bf16_t*)(ws + WS_U); bf16_t* MIX = (bf16_t*)(ws + WS_MIX); bf16_t* Zb = (bf16_t*)(ws + WS_Z);
            {
                float* T0 = (float*)(ws + WS_T0); const float* ngl = p.norm_g + (size_t)layer * 4 * D; const int b = blockIdx.x;
                LAS float* h = (LAS float*)lds; LAS float* u = h + 1024; LAS float* z = u + 1024; LAS float* mix = z + 4096; LAS float* y = mix + 1024; LAS float* red = y + 1024; LAS float* sc = red + 16;
                if (ph == 0) t0_skinny(odd ? p.od_w_in + (size_t)li * 1024 * OD_IN : p.ev_w_in + (size_t)li * 1024 * EV_IN, 1024, odd ? OD_IN : EV_IN, T0 + T0_U, 1024, T0 + T0_Z, 4096, 0, lds, tid);
                else if (ph == 4) t0_skinny((odd ? p.od_w_out : p.ev_w_out) + (size_t)li * 1024 * 1024, 1024, 1024, T0 + T0_MIX, 1024, T0 + T0_Y, 1024, 0, lds, tid);
                else if (ph == 6) t0_skinny(p.w_up + (size_t)layer * 1024 * FF, 1024, FF, T0 + T0_U, 1024, T0 + T0_Z, 4096, 2, lds, tid);
                else if (ph == 7) t0_skinny(p.w_down + (size_t)layer * FF * 1024, FF, 1024, T0 + T0_Z, 4096, T0 + T0_Y, 1024, 0, lds, tid);
                else if (b < NB && ph == 1) { t0_load(z, T0 + T0_Z + b * 4096, 4096, tid); if (odd) t0_mix_odd(p, li, z, mix, sc, tid); else t0_mix_even(p, li, z, mix, sc, tid);
                    t0_store(T0 + T0_MIX + b * 1024, mix, 1024, tid); }
                else { }
            }
            if (ph == 0 || ph == 4 || ph == 6 || ph == 7) {
                pg8::Gemm g; pg8::EpiSt E; E.Of0 = nullptr; E.Of1 = nullptr;
                if (ph == 0) { g.A = layer == 0 ? U : (const bf16_t*)(ws + WS_ST); g.K = 1024; E.O = Zb; E.act = 0;
                    if (!odd) { g.Bt = (const bf16_t*)(ws + WS_EVIN) + (size_t)li * EV_IN * 1024; g.N = EV_IN; E.ldc = EV_IN; E.nvalid = EV_IN; }
                    else { g.Bt = (const bf16_t*)(ws + WS_ODIN) + (size_t)li * OD_INP * 1024; g.N = OD_INP; E.ldc = OD_LD; E.nvalid = OD_IN; } }
                else if (ph == 4) { g.A = MIX; g.K = 1024; g.N = 1024; g.Bt = (const bf16_t*)(ws + (odd ? WS_ODOUT : WS_EVOUT)) + (size_t)li * 1024 * 1024; E.O = U; E.ldc = 1024; E.nvalid = 1024; E.act = 0; E.Of0 = (float*)Zb; }
                else if (ph == 6) { g.A = U; g.K = 1024; g.N = FF; g.Bt = (const bf16_t*)(ws + WS_UP) + (size_t)layer * FF * 1024; E.O = Zb; E.ldc = FF; E.nvalid = FF; E.act = 2; }
                else { g.A = Zb; g.K = FF; g.N = 1024; g.Bt = (const bf16_t*)(ws + WS_DN) + (size_t)layer * 1024 * FF; E.O = U; E.ldc = 1024; E.nvalid = 1024; E.act = 0; E.Of0 = (float*)MIX; }
                g.M = M;
                XcdOrder S; S.init(g.N, G, (int)blockIdx.x);
                pg8::gemm_phase<pg8::EpiSt, XcdOrder, PG8_ALIGN_OPT, PG8_SP2_OPT>(lds, g, S, E);
#ifdef PROBE_DOUBLE_GEMM
                __syncthreads(); pg8::gemm_phase<pg8::EpiSt, XcdOrder, PG8_ALIGN_OPT, PG8_SP2_OPT>(lds, g, S, E);
#endif
            }
#ifndef NO_MIX
            else if (ph == 1) {
#ifdef PROBE_DOUBLE_MIX
              for (int rep = 0; rep < 2; ++rep)
#endif
              {
                if (!odd) { for (int ul = rk; ul < 128 + 64; ul += NL) { if (ul < 128) la1_unit<false>(lds, p, li, bx * 128 + ul, 0, tid, wv, lane);
                                else { const int s = ul - 128; swa_unit(lds, Zb, MIX, p.ev_sinks + li * 8, bx, (s >> 5) & 1, s & 31, tid, wv, lane); } } }
                else { for (int ul = rk; ul < 128; ul += NL) la1_unit<true>(lds, p, li, bx * 128 + ul, 0, tid, wv, lane); }
              }
            } else if (ph == 2) {
                if (!odd) la2_phase<false>(p, tid, bx, rk, NL); else la2_phase<true>(p, tid, bx, rk, NL);
            } else if (ph == 3) {
#ifdef PROBE_DOUBLE_MIX
              for (int rep = 0; rep < 2; ++rep)
#endif
              {
                if (!odd) { for (int ul = rk; ul < 128; ul += NL) la3_unit<false>(lds, p, li, bx * 128 + ul, tid, wv, lane); }
                else { for (int ul = rk; ul < 128; ul += NL) la3_unit<true>(lds, p, li, bx * 128 + ul, tid, wv, lane); }
              }
            }
#endif
            else if (ph == 5) {
                norm_phase((const float*)Zb, nullptr, layer == 0 ? p.x : p.out, p.out, p.norm_g + (layer * 4 + 1) * D, p.norm_g + (layer * 4 + 2) * D, U, gw, NGW, lane, (float*)(ws + WS_T0), false);
            } else {
                norm_phase((const float*)MIX, nullptr, p.out, p.out, p.norm_g + (layer * 4 + 3) * D, layer + 1 < DEPTH ? p.norm_g + ((layer + 1) * 4) * D : nullptr, (bf16_t*)(ws + WS_ST), gw, NGW, lane, (float*)(ws + WS_T0), layer + 1 == DEPTH);
            }
            if (step + 1 < p.s_hi) GRID_SYNC();
#ifdef PROBE_DOUBLE_BAR
            if (step + 1 < p.s_hi) GRID_SYNC();
#endif
        }
    }
    if (p.s_hi > 1 + 9 * DEPTH) {
        if (blockIdx.x < NB) { const float* T0 = (const float*)(p.ws + WS_T0); for (int i = threadIdx.x; i < D; i += NTHREADS) p.out[(size_t)blockIdx.x * T * D + i] = T0[T0_H + blockIdx.x * 1024 + i]; }
    }
}

#ifdef DBG_SEPK
__global__ void __launch_bounds__(NTHREADS, 2) k_mix1_even(Params p, int li) {
    extern __shared__ __attribute__((aligned(16))) unsigned char lds_raw2[];
    LAS unsigned char* lds = (LAS unsigned char*)lds_raw2;
    const int tid = threadIdx.x, lane = tid & 63, wave = __builtin_amdgcn_readfirstlane(tid >> 6);
    const int bx = blockIdx.x & 7, rk = blockIdx.x >> 3, NL = gridDim.x >> 3;
    bf16_t* MIX = (bf16_t*)(p.ws + WS_MIX); bf16_t* Zb = (bf16_t*)(p.ws + WS_Z);
    for (int ul = rk; ul < 128 + 64; ul += NL) { if (ul < 128) la1_unit<false>(lds, p, li, bx * 128 + ul, 0, tid, wv, lane);
        else { const int s = ul - 128; swa_unit(lds, Zb, MIX, p.ev_sinks + li * 8, bx, (s >> 5) & 1, s & 31, tid, wv, lane); } }
}
#endif
#ifdef DBG_T0CHK
__global__ void __launch_bounds__(NTHREADS, 2) k_t0chk(Params p) {
    extern __shared__ __attribute__((aligned(16))) unsigned char lds_raw3[];
    LAS unsigned char* lds = (LAS unsigned char*)lds_raw3; const int tid = threadIdx.x, b = blockIdx.x;
    LAS float* h = (LAS float*)lds; LAS float* u = h + 1024; LAS float* z = u + 1024; LAS float* red = z + 4096 + 2048;
    h[tid] = p.x[(size_t)b * T * D + tid]; h[tid + 512] = p.x[(size_t)b * T * D + tid + 512]; __syncthreads();
    t0_rmsnorm_<false>(h, p.norm_g, u, red, tid);
    t0_gemv(p.ev_w_in, 1024, EV_IN, u, z, 0, tid);
    const bf16_t* Zr = (const bf16_t*)(p.ws + WS_Z) + (size_t)b * T * EV_IN; const bf16_t* Ur = (const bf16_t*)(p.ws + WS_U) + (size_t)b * T * D;
    bool bad = false;
    for (int n = tid; n < EV_IN; n += NTHREADS) { const float zm = __uint_as_float((unsigned)Zr[n] << 16); if (fabsf(zm - z[n]) > 0.05f + 0.02f * fabsf(zm)) bad = true; }
    if (DBG_T0CHK == 3) { bad = false; for (int n = tid; n < D; n += NTHREADS) { const float um = __uint_as_float((unsigned)Ur[n] << 16); if (fabsf(um - u[n]) > 0.02f + 0.01f * fabsf(um)) bad = true; } }
    if (DBG_T0CHK >= 10) { t0_path(p, lds, b, tid, DBG_T0CHK - 10); return; }
    if (DBG_T0CHK == 2) { LAS float* mix = z + 4096; LAS float* sc = red + 16; t0_mix_even(p, 0, z, mix, sc, tid);
        const bf16_t* Mr = (const bf16_t*)(p.ws + WS_MIX) + (size_t)b * T * D; bad = false;
        for (int n = tid; n < D; n += NTHREADS) { const float mm = __uint_as_float((unsigned)Mr[n] << 16); if (fabsf(mm - mix[n]) > 0.05f + 0.05f * fabsf(mm)) bad = true; } }
    if (DBG_T0CHK == 5) { LAS float* mix = z + 4096; LAS float* sc = red + 16; LAS float* y = mix + 1024; t0_mix_even(p, 0, z, mix, sc, tid);
        t0_gemv(p.ev_w_out, 1024, 1024, mix, y, 0, tid); bad = false;
        for (int n = tid; n < D; n += NTHREADS) { const float um = __uint_as_float((unsigned)Ur[n] << 16); if (fabsf(um - y[n]) > 0.03f + 0.05f * fabsf(um)) bad = true; } }
    if (DBG_T0CHK == 6) { LAS float* mix = z + 4096; LAS float* sc = red + 16; LAS float* y = mix + 1024; t0_mix_even(p, 0, z, mix, sc, tid);
        t0_gemv(p.ev_w_out, 1024, 1024, mix, y, 0, tid); t0_rmsnorm_<true>(y, p.norm_g + D, h, red, tid); t0_rmsnorm_<false>(h, p.norm_g + 2 * D, u, red, tid); bad = false;
        for (int n = tid; n < D; n += NTHREADS) { const float hm = p.out[(size_t)b * T * D + n]; if (fabsf(hm - h[n]) > 0.03f + 0.03f * fabsf(hm)) bad = true;
            const float um = __uint_as_float((unsigned)Ur[n] << 16); if (fabsf(um - u[n]) > 0.03f + 0.03f * fabsf(um)) bad = true; } }
    __syncthreads();
    if (bad) p.out[(size_t)(b * T + T - 1) * D + tid] = __builtin_nanf("");
}
#endif
#ifdef DBG_STEPS
__global__ void dbg_dump(Params p) {
    const bf16_t* src = (const bf16_t*)(p.ws + (size_t)DBG_OFF_MIB * MiB);
    for (size_t idx = (size_t)blockIdx.x * blockDim.x + threadIdx.x; idx < (size_t)M * D; idx += (size_t)gridDim.x * blockDim.x) { const size_t m = idx >> 10, c = idx & 1023;
#ifndef DBG_W
#define DBG_W 1024
#endif
        p.out[idx] = c < DBG_W ? __uint_as_float((unsigned)src[m * DBG_LD + DBG_COL + c] << 16) : 0.f; }
}
#endif
extern "C" void kernel_launch(void* const* d_in, const int* in_sizes, int n_in, void* d_out, int out_size, void* d_ws, size_t ws_size, hipStream_t stream) {
    static int grid = 0;
    if (grid == 0) {
        if (n_in != 13 || in_sizes[0] != M * D || out_size != M * D || ws_size < WS_END) { fprintf(stderr, "kernel_launch: unexpected shapes / workspace (n_in %d, ws %zu)\n", n_in, ws_size); grid = -1; return; }
        int dev = 0, cus = 0, per_cu = 0;
        hipGetDevice(&dev); hipDeviceGetAttribute(&cus, hipDeviceAttributeMultiprocessorCount, dev);
        if (hipFuncSetAttribute((const void*)mega_fwd, hipFuncAttributeMaxDynamicSharedMemorySize, LDS_BYTES) != hipSuccess) { fprintf(stderr, "kernel_launch: hipFuncSetAttribute failed\n"); grid = -1; return; }
        if (hipOccupancyMaxActiveBlocksPerMultiprocessor(&per_cu, (const void*)mega_fwd, NTHREADS, LDS_BYTES) != hipSuccess || per_cu < 1) { fprintf(stderr, "kernel_launch: occupancy query gave %d\n", per_cu); per_cu = 1; }
        (void)hipGetLastError();
        grid = cus * per_cu;
    }
    if (grid < 0) return;
    Params p{};
    p.x = (const float*)d_in[0]; p.norm_g = (const float*)d_in[1]; p.w_up = (const float*)d_in[2]; p.w_down = (const float*)d_in[3]; p.ev_w_in = (const float*)d_in[4];
    p.ev_ret_norm_g = (const float*)d_in[5]; p.ev_sinks = (const float*)d_in[6]; p.ev_w_out = (const float*)d_in[7]; p.od_w_in = (const float*)d_in[8]; p.od_w_gate_up = (const float*)d_in[9];
    p.od_gate_bias = (const float*)d_in[10]; p.od_norm_g = (const float*)d_in[11]; p.od_w_out = (const float*)d_in[12];
    p.out = (float*)d_out; p.ws = (unsigned char*)d_ws;
    if (hipMemsetAsync((char*)d_ws + WS_CTL, 0, 16384, stream) != hipSuccess) { fprintf(stderr, "kernel_launch: memset failed\n"); return; }
#ifndef MK_PER_PHASE
#define MK_PER_PHASE 0
#endif
    constexpr int NSTEPS = 1 + 9 * DEPTH;
    if (MK_PER_PHASE) {
#ifdef DBG_STEPS
#ifndef DBG_SKIP_LO
#define DBG_SKIP_LO 0
#define DBG_SKIP_HI 0
#endif
#ifdef DBG_SEPK
        hipFuncSetAttribute((const void*)k_mix1_even, hipFuncAttributeMaxDynamicSharedMemorySize, LDS_BYTES);
#endif
        for (int st = 0; st < DBG_STEPS; ++st) { if (st >= DBG_SKIP_LO && st < DBG_SKIP_HI) continue; p.s_lo = st; p.s_hi = st + 1;
#ifdef DBG_SEPK
            if (st == 2) { hipLaunchKernelGGL(k_mix1_even, dim3(grid), dim3(NTHREADS), LDS_BYTES, stream, p, 0); continue; }
#endif
            hipLaunchKernelGGL(mega_fwd, dim3(grid), dim3(NTHREADS), LDS_BYTES, stream, p); }
#ifndef DBG_NODUMP
        hipLaunchKernelGGL(dbg_dump, dim3(2048), dim3(256), 0, stream, p);
#endif
#ifdef DBG_T0CHK
        hipLaunchKernelGGL(k_t0chk, dim3(8), dim3(NTHREADS), 65536, stream, p);
#endif
#else
        for (int st = 0; st < NSTEPS; ++st) { p.s_lo = st; p.s_hi = st + 1; hipLaunchKernelGGL(mega_fwd, dim3(grid), dim3(NTHREADS), LDS_BYTES, stream, p); }
#endif
    } else {
        p.s_lo = 0; p.s_hi = NSTEPS;
        void* args[] = {&p};
        hipError_t e = hipLaunchCooperativeKernel((const void*)mega_fwd, dim3(grid), dim3(NTHREADS), args, LDS_BYTES, stream);
        if (e != hipSuccess) fprintf(stderr, "kernel_launch: cooperative launch failed: %s (grid %d)\n", hipGetErrorString(e), grid);
    }
}
```

```cpp
#include <hip/hip_runtime.h>
#include <cstdio>
#include <cstdint>
#include <cmath>
namespace pg8 {
#define PG8_LAS __attribute__((address_space(3)))
typedef unsigned short bf16_t;
typedef short bf16x8 __attribute__((ext_vector_type(8)));
typedef float f32x4 __attribute__((ext_vector_type(4)));
typedef unsigned u32x4 __attribute__((ext_vector_type(4)));
constexpr int BM = 256, BK = 64, HALF = 128, HTB = HALF * BK * 2  , STAGE_BYTES = 8 * HTB, NXCD = 8, WGM = 8;

__host__ __device__ __forceinline__ int lds_byte(int r, int c) { const int st = (r >> 4) * 2 + (c >> 5), rr = r & 15, cc = c & 31, ob = rr * 64 + cc * 2; return st * 1024 + (ob ^ (((ob >> 9) & 1) << 5)); }
__host__ __device__ __forceinline__ void stage_rc(int b, int& R, int& C) { const int st = b / 1024, sb = b % 1024, swz = sb ^ (((sb >> 9) & 1) << 5); R = (st >> 1) * 16 + swz / 64; C = (st & 1) * 32 + (swz % 64) / 2; }
__host__ __device__ __forceinline__ int perm32(int rho) { const int n = rho >> 4, i = rho & 15; return 8 * (i >> 2) + 4 * n + (i & 3); }

struct Unit { int pm, pn; };
struct Gemm { const bf16_t* A; const bf16_t* Bt; int M, N, K; };

struct StaticOrder {
    int nM, nN, nwg, G, c;
    __host__ __device__ void init(int M, int N, int G_, int c_) { nM = M / BM; nN = N / BM; nwg = nM * nN; G = G_; c = c_; }
    __host__ __device__ bool next(int i, Unit& u) const {
        const long L = (long)i * G + c; if (L >= nwg) return false;
        int wgid = (int)L; { const int q = nwg / NXCD, r = nwg % NXCD, xcd = wgid % NXCD, off = wgid / NXCD; wgid = (xcd < r ? xcd * (q + 1) : r * (q + 1) + (xcd - r) * q) + off; }
        const int nig = WGM * nN, gid = wgid / nig, fm = gid * WGM, gsz = (nM - fm) < WGM ? (nM - fm) : WGM;
        u.pm = fm + ((wgid % nig) % gsz); u.pn = (wgid % nig) / gsz; return true;
    }
    __device__ __forceinline__ void a_ready(const Unit&) const {}
    __device__ __forceinline__ void done(const Unit&) const {}
};

typedef __bf16 bf16x2_t __attribute__((ext_vector_type(2)));
typedef float f32x2_t __attribute__((ext_vector_type(2)));
__device__ __forceinline__ unsigned cvt_pk_bf16(float lo, float hi) { const f32x2_t v = {lo, hi}; const bf16x2_t b = __builtin_convertvector(v, bf16x2_t); return __builtin_bit_cast(unsigned, b); }
struct EpiSt {
    static constexpr bool PERM = true, AFTER_DRAIN = false;
    bf16_t* O; int ldc; int nvalid; int act; float* Of0; float* Of1;
    __device__ __forceinline__ void operator()(const f32x4 (&acc)[2][2][4][2], const Unit& u, int wr, int wc, int fr, int fq) const {
        const int row0 = u.pm * BM + wr * 64 + fr; const int col0 = u.pn * BM + wc * 32 + 8 * fq;
        if (Of0) {
            typedef _Float16 h2_t __attribute__((ext_vector_type(2))); typedef float f2_t __attribute__((ext_vector_type(2)));
            unsigned short* Oh = (unsigned short*)Of0;
#pragma unroll
            for (int ai = 0; ai < 2; ++ai)
#pragma unroll
                for (int m = 0; m < 4; ++m) { unsigned short* rowp = Oh + (size_t)(row0 + ai * HALF + m * 16) * 1024 + col0;
#pragma unroll
                    for (int bj = 0; bj < 2; ++bj) { const f32x4 v0 = acc[ai][bj][m][0], v1 = acc[ai][bj][m][1]; u32x4 w;
                        w.x = __builtin_bit_cast(unsigned, __builtin_convertvector((f2_t){v0[0], v0[1]}, h2_t)); w.y = __builtin_bit_cast(unsigned, __builtin_convertvector((f2_t){v0[2], v0[3]}, h2_t));
                        w.z = __builtin_bit_cast(unsigned, __builtin_convertvector((f2_t){v1[0], v1[1]}, h2_t)); w.w = __builtin_bit_cast(unsigned, __builtin_convertvector((f2_t){v1[2], v1[3]}, h2_t));
                        *(u32x4*)(rowp + bj * HALF) = w; } }
            return;
        }
#pragma unroll
        for (int ai = 0; ai < 2; ++ai)
#pragma unroll
            for (int m = 0; m < 4; ++m) { bf16_t* rowp = O + (size_t)(row0 + ai * HALF + m * 16) * ldc + col0;
#pragma unroll
                for (int bj = 0; bj < 2; ++bj) { f32x4 v0 = acc[ai][bj][m][0], v1 = acc[ai][bj][m][1];
                    if (act == 2) {
#pragma unroll
                        for (int e = 0; e < 4; ++e) { const float a = fmaxf(v0[e], 0.f), b = fmaxf(v1[e], 0.f); v0[e] = a * a; v1[e] = b * b; } }
                    u32x4 w; w.x = cvt_pk_bf16(v0[0], v0[1]); w.y = cvt_pk_bf16(v0[2], v0[3]); w.z = cvt_pk_bf16(v1[0], v1[1]); w.w = cvt_pk_bf16(v1[2], v1[3]);
                    if (col0 + bj * HALF + 8 <= nvalid) *(u32x4*)(rowp + bj * HALF) = w; } }
    }
};

template <class Epi, class Sched, bool ALIGN_EPI = false, bool SP2 = false>
__device__ __forceinline__ void gemm_phase(PG8_LAS unsigned char* lds, const Gemm g, const Sched& S, const Epi& E) {
    int tid = threadIdx.x; asm volatile("" : "+v"(tid));
    const int wid = __builtin_amdgcn_readfirstlane(tid >> 6), lane = tid & 63, wr = wid >> 2, wc = wid & 3, fr = lane & 15, fq = lane >> 4;
    const int K = g.K, nt = K / BK;
    unsigned voffA[2], voffB[2];
#pragma unroll
    for (int i = 0; i < 2; ++i) { int R, C; stage_rc(tid * 16 + i * 8192, R, C); const int Rb = Epi::PERM ? ((R & ~31) + perm32(R & 31)) : R;
        voffA[i] = (unsigned)(R * K + C) * 2u; voffB[i] = (unsigned)(Rb * K + C) * 2u; }
    const size_t kstep = (size_t)(BK * 2);
    const size_t hstep = (size_t)HALF * K * 2;
    const size_t tstep = 2 * hstep;
    const unsigned ldsw = (unsigned)wid * 1024u;
    const int aoff = lds_byte(wr * 64 + fr, fq * 8), boff = lds_byte(wc * 32 + fr, fq * 8);
#define PG8_SA(b, h) (((b) * 2 + (h)) * HTB)
#define PG8_SB(b, h) ((4 + (b) * 2 + (h)) * HTB)
#define PG8_STAGE(bufoff, gbase, voff) do { _Pragma("unroll") for (int _i = 0; _i < 2; ++_i) \
        __builtin_amdgcn_global_load_lds((const unsigned*)((const char*)(gbase) + (voff)[_i]), (PG8_LAS unsigned*)(lds + (bufoff) + ldsw + _i * 8192), 16, 0, 0); } while (0)
#define PG8_LDA(dst, b, h) do { _Pragma("unroll") for (int m = 0; m < 4; ++m) _Pragma("unroll") for (int k = 0; k < 2; ++k) dst[m][k] = *(const PG8_LAS bf16x8*)(lds + PG8_SA(b, h) + aoff + m * 2048 + k * 1024); } while (0)
#define PG8_LDB(dst, b, h) do { _Pragma("unroll") for (int n = 0; n < 2; ++n) _Pragma("unroll") for (int k = 0; k < 2; ++k) dst[n][k] = *(const PG8_LAS bf16x8*)(lds + PG8_SB(b, h) + boff + n * 2048 + k * 1024); } while (0)
#define PG8_MMA(ai, bj, At, Bt) do { __builtin_amdgcn_s_setprio(1); _Pragma("unroll") for (int m = 0; m < 4; ++m) _Pragma("unroll") for (int n = 0; n < 2; ++n) _Pragma("unroll") for (int k = 0; k < 2; ++k) \
        acc[ai][bj][m][n] = __builtin_amdgcn_mfma_f32_16x16x32_bf16(Bt[n][k], At[m][k], acc[ai][bj][m][n], 0, 0, 0); __builtin_amdgcn_s_setprio(0); } while (0)
#define PG8_WAIT_V(n) asm volatile("s_waitcnt vmcnt(" #n ")" ::: "memory")
#define PG8_WAIT_L(n) asm volatile("s_waitcnt lgkmcnt(" #n ")" ::: "memory")
#define PG8_BAR __builtin_amdgcn_s_barrier()
#define PG8_SCHED __builtin_amdgcn_sched_barrier(0)
    Unit cur, nxt; int ui = 0;
    if (!S.next(0, cur)) return;
    f32x4 acc[2][2][4][2];
#pragma unroll
    for (int a = 0; a < 2; ++a)
#pragma unroll
        for (int b = 0; b < 2; ++b)
#pragma unroll
            for (int m = 0; m < 4; ++m)
#pragma unroll
                for (int n = 0; n < 2; ++n) acc[a][b][m][n] = (f32x4){0.f, 0.f, 0.f, 0.f};
    bf16x8 At[4][2], B0[2][2], B1[2][2];
    const char* cA = (const char*)g.A + (size_t)cur.pm * tstep; const char* cB = (const char*)g.Bt + (size_t)cur.pn * tstep;
    S.a_ready(cur);
    if constexpr (SP2) {
        PG8_STAGE(PG8_SB(0, 0), cB, voffB); PG8_STAGE(PG8_SB(0, 1), cB + hstep, voffB); PG8_STAGE(PG8_SA(0, 0), cA, voffA); PG8_STAGE(PG8_SA(0, 1), cA + hstep, voffA);
        if (wr == 1) PG8_BAR;
        PG8_WAIT_V(2); PG8_BAR;
        PG8_STAGE(PG8_SB(1, 0), cB + kstep, voffB); PG8_STAGE(PG8_SA(1, 0), cA + kstep, voffA); PG8_STAGE(PG8_SB(1, 1), cB + hstep + kstep, voffB);
        PG8_WAIT_V(6); PG8_BAR;
    } else {
        PG8_STAGE(PG8_SB(0, 0), cB, voffB); PG8_STAGE(PG8_SA(0, 0), cA, voffA); PG8_STAGE(PG8_SB(0, 1), cB + hstep, voffB); PG8_STAGE(PG8_SA(0, 1), cA + hstep, voffA);
        if (wr == 1) PG8_BAR;
        PG8_WAIT_V(4); PG8_BAR;
        PG8_STAGE(PG8_SB(1, 0), cB + kstep, voffB); PG8_STAGE(PG8_SA(1, 0), cA + kstep, voffA); PG8_STAGE(PG8_SB(1, 1), cB + hstep + kstep, voffB);
        PG8_WAIT_V(6); PG8_BAR;
    }
    for (;;) {
        const bool has_next = S.next(ui + 1, nxt);
        const char* nA = has_next ? (const char*)g.A + (size_t)nxt.pm * tstep : cA; const char* nB = has_next ? (const char*)g.Bt + (size_t)nxt.pn * tstep : cB;
        for (int t = 0; t < nt; t += 2) {
            const bool last = (t == nt - 2);
            const char* a1 = cA + (size_t)(t + 1) * kstep;
            const char* a2 = last ? nA : cA + (size_t)(t + 2) * kstep; const char* b2 = last ? nB : cB + (size_t)(t + 2) * kstep;
            const char* a3 = a2 + kstep; const char* b3 = b2 + kstep;
            if (last && has_next) S.a_ready(nxt);
            if constexpr (SP2) {
            PG8_LDB(B0, 0, 0); PG8_LDB(B1, 0, 1); PG8_SCHED; PG8_LDA(At, 0, 0); PG8_STAGE(PG8_SA(1, 1), a1 + hstep, voffA);
            PG8_WAIT_V(8); PG8_WAIT_L(0); PG8_BAR; PG8_MMA(0, 0, At, B0); PG8_MMA(0, 1, At, B1); PG8_BAR; PG8_SCHED;
            PG8_LDA(At, 0, 1); PG8_STAGE(PG8_SB(0, 0), b2, voffB); PG8_STAGE(PG8_SB(0, 1), b2 + hstep, voffB); PG8_STAGE(PG8_SA(0, 0), a2, voffA);
            PG8_WAIT_V(8); PG8_WAIT_L(0); PG8_BAR; PG8_MMA(1, 0, At, B0); PG8_MMA(1, 1, At, B1); PG8_BAR; PG8_SCHED;
            PG8_LDB(B0, 1, 0); PG8_LDB(B1, 1, 1); PG8_SCHED; PG8_LDA(At, 1, 0); PG8_STAGE(PG8_SA(0, 1), a2 + hstep, voffA);
            PG8_WAIT_V(8); PG8_WAIT_L(0); PG8_BAR; PG8_MMA(0, 0, At, B0); PG8_MMA(0, 1, At, B1); PG8_BAR; PG8_SCHED;
            PG8_LDA(At, 1, 1); PG8_STAGE(PG8_SB(1, 0), b3, voffB); PG8_STAGE(PG8_SB(1, 1), b3 + hstep, voffB); PG8_STAGE(PG8_SA(1, 0), a3, voffA);
            PG8_WAIT_V(8); PG8_WAIT_L(0); PG8_BAR; PG8_MMA(1, 0, At, B0); PG8_MMA(1, 1, At, B1); PG8_BAR; PG8_SCHED;
            } else {
            PG8_LDB(B0, 0, 0); PG8_SCHED; PG8_LDA(At, 0, 0); PG8_STAGE(PG8_SA(1, 1), a1 + hstep, voffA);
            PG8_WAIT_L(8); PG8_BAR; PG8_WAIT_L(0); PG8_MMA(0, 0, At, B0); PG8_BAR; PG8_SCHED;
            PG8_LDB(B1, 0, 1); PG8_STAGE(PG8_SB(0, 0), b2, voffB);
            PG8_BAR; PG8_WAIT_L(0); PG8_MMA(0, 1, At, B1); PG8_BAR;
            PG8_LDA(At, 0, 1); PG8_STAGE(PG8_SA(0, 0), a2, voffA);
            PG8_BAR; PG8_WAIT_L(0); PG8_MMA(1, 0, At, B0); PG8_BAR; PG8_SCHED;
            PG8_STAGE(PG8_SB(0, 1), b2 + hstep, voffB);
            PG8_WAIT_V(6); PG8_BAR; PG8_MMA(1, 1, At, B1); PG8_BAR;
            PG8_LDB(B0, 1, 0); PG8_SCHED; PG8_LDA(At, 1, 0); PG8_STAGE(PG8_SA(0, 1), a2 + hstep, voffA);
            PG8_WAIT_L(8); PG8_BAR; PG8_WAIT_L(0); PG8_MMA(0, 0, At, B0); PG8_BAR; PG8_SCHED;
            PG8_LDB(B1, 1, 1); PG8_STAGE(PG8_SB(1, 0), b3, voffB);
            PG8_BAR; PG8_WAIT_L(0); PG8_MMA(0, 1, At, B1); PG8_BAR;
            PG8_LDA(At, 1, 1); PG8_STAGE(PG8_SA(1, 0), a3, voffA);
            PG8_BAR; PG8_WAIT_L(0); PG8_MMA(1, 0, At, B0); PG8_BAR; PG8_SCHED;
            PG8_STAGE(PG8_SB(1, 1), b3 + hstep, voffB);
            PG8_WAIT_V(6); PG8_BAR; PG8_MMA(1, 1, At, B1); PG8_BAR;
            }
        }
        if constexpr (ALIGN_EPI) { if (wr == 0) PG8_BAR; }
        if constexpr (!Epi::AFTER_DRAIN) { E(acc, cur, wr, wc, fr, fq); S.done(cur); }
        if (!has_next) break;
#pragma unroll
        for (int a = 0; a < 2; ++a)
#pragma unroll
            for (int b = 0; b < 2; ++b)
#pragma unroll
                for (int m = 0; m < 4; ++m)
#pragma unroll
                    for (int n = 0; n < 2; ++n) acc[a][b][m][n] = (f32x4){0.f, 0.f, 0.f, 0.f};
        cur = nxt; cA = nA; cB = nB; ++ui;
        if constexpr (ALIGN_EPI) { if (wr == 1) PG8_BAR; }
    }
    PG8_WAIT_V(0);
    if constexpr (!ALIGN_EPI) { if (wr == 0) PG8_BAR; }
    PG8_BAR;
    if constexpr (Epi::AFTER_DRAIN) { E.fused(acc, cur, wr, wc, fr, fq, lds, wid, lane); S.done(cur); }
#undef PG8_SA
#undef PG8_SB
#undef PG8_STAGE
#undef PG8_LDA
#undef PG8_LDB
#undef PG8_MMA
#undef PG8_WAIT_V
#undef PG8_WAIT_L
#undef PG8_BAR
#undef PG8_SCHED
}
}
#include <hip/hip_cooperative_groups.h>
namespace cg = cooperative_groups;
#define LAS __attribute__((address_space(3)))
typedef unsigned short bf16_t;
typedef short bf16x8 __attribute__((ext_vector_type(8)));
typedef float f32x4 __attribute__((ext_vector_type(4)));
typedef unsigned u32x4 __attribute__((ext_vector_type(4)));
typedef unsigned u32x2 __attribute__((ext_vector_type(2)));

constexpr int NB = 8, T = 4096, D = 1024, M = NB * T, FF = 4096, DEPTH = 4;
constexpr int EV_IN = 2816, OD_IN = 3088, OD_INP = 3328, OD_LD = 3328;
constexpr float EPS = 1e-6f;
constexpr int NTHREADS = 512, NWAVES = 8;
constexpr int LDS_BYTES = 147456;

constexpr size_t MiB = 1u << 20;
constexpr size_t WS_EVIN = 0;
constexpr size_t WS_ODIN = 11 * MiB;
constexpr size_t WS_UP = 24 * MiB;
constexpr size_t WS_DN = 56 * MiB;
constexpr size_t WS_EVOUT = 88 * MiB;
constexpr size_t WS_ODOUT = 92 * MiB;
constexpr size_t WS_ROT = 96 * MiB;
constexpr size_t WS_U = 98 * MiB;
constexpr size_t WS_MIX = 162 * MiB;
constexpr size_t WS_Z = 226 * MiB;
constexpr size_t WS_ST = 434 * MiB;
constexpr size_t WS_DEC = 498 * MiB;
constexpr size_t WS_CTL = 499 * MiB;
constexpr size_t WS_END = 500 * MiB;

struct Params {
    const float* x; const float* norm_g; const float* w_up; const float* w_down; const float* ev_w_in; const float* ev_ret_norm_g; const float* ev_sinks;
    const float* ev_w_out; const float* od_w_in; const float* od_w_gate_up; const float* od_gate_bias; const float* od_norm_g; const float* od_w_out;
    float* out; unsigned char* ws;
    int s_lo, s_hi;
};

__device__ __forceinline__ float wave_sum(float v) {
#pragma unroll
    for (int o = 1; o < 64; o <<= 1) v += __shfl_xor(v, o);
    return v;
}
__device__ __forceinline__ float lo_bf(unsigned w) { return __uint_as_float(w << 16); }
__device__ __forceinline__ float hi_bf(unsigned w) { return __uint_as_float(w & 0xffff0000u); }
__device__ __forceinline__ unsigned pk2(float lo, float hi) { return pg8::cvt_pk_bf16(lo, hi); }
__device__ __forceinline__ unsigned short f2bf(float f) { return (unsigned short)(pg8::cvt_pk_bf16(f, 0.f) & 0xffffu); }
__device__ __forceinline__ void unpack8(const u32x4 v, float (&f)[8]) {
    f[0] = lo_bf(v.x); f[1] = hi_bf(v.x); f[2] = lo_bf(v.y); f[3] = hi_bf(v.y); f[4] = lo_bf(v.z); f[5] = hi_bf(v.z); f[6] = lo_bf(v.w); f[7] = hi_bf(v.w);
}
__device__ __forceinline__ u32x4 pack8(const float (&f)[8]) { u32x4 w; w.x = pk2(f[0], f[1]); w.y = pk2(f[2], f[3]); w.z = pk2(f[4], f[5]); w.w = pk2(f[6], f[7]); return w; }
#define LDS_WAIT() asm volatile("s_waitcnt lgkmcnt(0)" ::: "memory")
#define MFMA16(b, a, c) __builtin_amdgcn_mfma_f32_16x16x32_bf16((b), (a), (c), 0, 0, 0)

__device__ __forceinline__ void transpose_item(const float* W, int K, int N, bf16_t* WT, LAS float* scr, int item, int nblk, int lane) {
    const int kb = item / nblk, nb = item % nblk, k0 = 64 * kb, n0 = 32 * nb;
    const int nn = n0 + (lane & 31); const bool ok = nn < N;
    float v[32];
    const float* wp = W + (size_t)(k0 + (lane >> 5)) * N + (ok ? nn : 0);
#pragma unroll
    for (int i = 0; i < 32; ++i) v[i] = wp[(size_t)(2 * i) * N];
#pragma unroll
    for (int i = 0; i < 32; ++i) { const int kk = 2 * i + (lane >> 5); scr[kk * 33 + (lane & 31)] = ok ? v[i] : 0.f; }
    LDS_WAIT();
    const int c = lane & 7;
#pragma unroll
    for (int j = 0; j < 4; ++j) { const int n = (lane >> 3) + 8 * j; const LAS float* s = scr + (8 * c) * 33 + n;
        u32x4 o; o.x = pk2(s[0 * 33], s[1 * 33]); o.y = pk2(s[2 * 33], s[3 * 33]); o.z = pk2(s[4 * 33], s[5 * 33]); o.w = pk2(s[6 * 33], s[7 * 33]);
        *(u32x4*)(WT + (size_t)(n0 + n) * K + k0 + 8 * c) = o; }
    LDS_WAIT();
}
__device__ __forceinline__ void mat_desc(const Params& p, int mi, const float*& W, int& K, int& N, int& NP, bf16_t*& WT) {
    unsigned char* ws = p.ws;
    if (mi < 2) { W = p.ev_w_in + (size_t)mi * 1024 * EV_IN; K = 1024; N = EV_IN; NP = EV_IN; WT = (bf16_t*)(ws + WS_EVIN) + (size_t)mi * EV_IN * 1024; }
    else if (mi < 4) { const int i = mi - 2; W = p.od_w_in + (size_t)i * 1024 * OD_IN; K = 1024; N = OD_IN; NP = OD_INP; WT = (bf16_t*)(ws + WS_ODIN) + (size_t)i * OD_INP * 1024; }
    else if (mi < 8) { const int l = mi - 4; W = p.w_up + (size_t)l * 1024 * FF; K = 1024; N = FF; NP = FF; WT = (bf16_t*)(ws + WS_UP) + (size_t)l * FF * 1024; }
    else if (mi < 12) { const int l = mi - 8; W = p.w_down + (size_t)l * FF * 1024; K = FF; N = 1024; NP = 1024; WT = (bf16_t*)(ws + WS_DN) + (size_t)l * 1024 * FF; }
    else if (mi < 14) { const int i = mi - 12; W = p.ev_w_out + (size_t)i * 1024 * 1024; K = 1024; N = 1024; NP = 1024; WT = (bf16_t*)(ws + WS_EVOUT) + (size_t)i * 1024 * 1024; }
    else { const int i = mi - 14; W = p.od_w_out + (size_t)i * 1024 * 1024; K = 1024; N = 1024; NP = 1024; WT = (bf16_t*)(ws + WS_ODOUT) + (size_t)i * 1024 * 1024; }
}

__device__ __forceinline__ void norm_phase(const float* Y, const float* Y1, const float* hin, float* hout, const float* g_post, const float* g_pre, bf16_t* U, int gw, int NGW, int lane, float* t0 = nullptr, bool t0_final = false) {
    const int bx = gw / NWAVES % 8, lw = (gw / NWAVES / 8) * NWAVES + gw % NWAVES, NLW = NGW / 8;
    constexpr int NR = 4;
    for (int ml = lw; ml < T; ml += NR * NLW) {
        int m[NR];
#pragma unroll
        for (int q = 0; q < NR; ++q) m[q] = bx * T + ml + q * NLW;
        f32x4 h[NR][4], y[NR][4];
#pragma unroll
        for (int q = 0; q < NR; ++q) { const f32x4* hr = (const f32x4*)(hin + (size_t)m[q] * D) + lane;
#pragma unroll
            for (int j = 0; j < 4; ++j) h[q][j] = __builtin_nontemporal_load(&hr[64 * j]);
            if (Y) { typedef _Float16 h4_t __attribute__((ext_vector_type(4))); const h4_t* yr = (const h4_t*)((const unsigned short*)Y + (size_t)m[q] * D) + lane;
#pragma unroll
                for (int j = 0; j < 4; ++j) { const h4_t yh = __builtin_nontemporal_load(&yr[64 * j]); y[q][j] = (f32x4){(float)yh[0], (float)yh[1], (float)yh[2], (float)yh[3]}; } } }
        if (Y) {
            float s[NR];
#pragma unroll
            for (int q = 0; q < NR; ++q) { s[q] = 0.f;
#pragma unroll
                for (int j = 0; j < 4; ++j) s[q] += (y[q][j][0] * y[q][j][0] + y[q][j][1] * y[q][j][1]) + (y[q][j][2] * y[q][j][2] + y[q][j][3] * y[q][j][3]); }

#pragma unroll
            for (int q = 0; q < NR; ++q) s[q] = wave_sum(s[q]);
            const f32x4* gp = (const f32x4*)g_post + lane;
#pragma unroll
            for (int q = 0; q < NR; ++q) { const float r = rsqrtf(s[q] * (1.f / D) + EPS); f32x4* ho = (f32x4*)(hout + (size_t)m[q] * D) + lane;
#pragma unroll
                for (int j = 0; j < 4; ++j) { h[q][j] = h[q][j] + y[q][j] * r * gp[64 * j]; __builtin_nontemporal_store(h[q][j], &ho[64 * j]); } }
        }
        if (g_pre) {
            float s[NR];
#pragma unroll
            for (int q = 0; q < NR; ++q) { s[q] = 0.f;
#pragma unroll
                for (int j = 0; j < 4; ++j) s[q] += (h[q][j][0] * h[q][j][0] + h[q][j][1] * h[q][j][1]) + (h[q][j][2] * h[q][j][2] + h[q][j][3] * h[q][j][3]); }

#pragma unroll
            for (int q = 0; q < NR; ++q) s[q] = wave_sum(s[q]);
            const f32x4* gp = (const f32x4*)g_pre + lane;
#pragma unroll
            for (int q = 0; q < NR; ++q) { const float r = rsqrtf(s[q] * (1.f / D) + EPS); u32x2* uo = (u32x2*)(U + (size_t)m[q] * D) + lane;
#pragma unroll
                for (int j = 0; j < 4; ++j) { const f32x4 v = h[q][j] * r * gp[64 * j]; u32x2 w; w.x = pk2(v[0], v[1]); w.y = pk2(v[2], v[3]); uo[64 * j] = w; } }
        }
    }
    if (t0 && lw == 0) {
        constexpr int T0_H_ = 0, T0_U_ = 8192, T0_Y_ = 57344;
        f32x4* hr = (f32x4*)(t0 + T0_H_ + bx * 1024) + lane; const f32x4* yr = (const f32x4*)(t0 + T0_Y_ + bx * 1024) + lane;
        f32x4 h[4], y[4]; float s = 0.f;
#pragma unroll
        for (int j = 0; j < 4; ++j) { h[j] = hr[64 * j]; y[j] = yr[64 * j]; s += (y[j][0] * y[j][0] + y[j][1] * y[j][1]) + (y[j][2] * y[j][2] + y[j][3] * y[j][3]); }
        const float r = rsqrtf(wave_sum(s) * (1.f / D) + EPS); const f32x4* gp = (const f32x4*)g_post + lane;
#pragma unroll
        for (int j = 0; j < 4; ++j) { h[j] = h[j] + y[j] * r * gp[64 * j]; hr[64 * j] = h[j]; }
        if (t0_final) { f32x4* ho = (f32x4*)(hout + (size_t)bx * T * D) + lane;
#pragma unroll
            for (int j = 0; j < 4; ++j) ho[64 * j] = h[j]; }
        if (g_pre) { float s2 = 0.f;
#pragma unroll
            for (int j = 0; j < 4; ++j) s2 += (h[j][0] * h[j][0] + h[j][1] * h[j][1]) + (h[j][2] * h[j][2] + h[j][3] * h[j][3]);
            const float r2 = rsqrtf(wave_sum(s2) * (1.f / D) + EPS); const f32x4* gq = (const f32x4*)g_pre + lane; f32x4* ur = (f32x4*)(t0 + T0_U_ + bx * 1024) + lane;
#pragma unroll
            for (int j = 0; j < 4; ++j) ur[64 * j] = h[j] * r2 * gq[64 * j]; }
    }
}
__device__ __forceinline__ void prologue_phase(const Params& p, LAS unsigned char* lds, int tid, int wave, int lane) {
    const int G = gridDim.x, gw = blockIdx.x * NWAVES + wave, NGW = G * NWAVES;
    LAS float* scr = (LAS float*)(lds + wave * 16384);
    constexpr int NITEMS = 2 * 16 * 88 + 2 * 16 * 104 + 4 * 16 * 128 + 4 * 64 * 32 + 4 * 16 * 32;
    for (int it = gw; it < NITEMS; it += NGW) {
        int r = it, mi = 0;
        for (; mi < 16; ++mi) { const int cnt = mi < 2 ? 16 * 88 : mi < 4 ? 16 * 104 : mi < 8 ? 16 * 128 : mi < 12 ? 64 * 32 : 16 * 32; if (r < cnt) break; r -= cnt; }
        const float* W; int K, N, NP; bf16_t* WT; mat_desc(p, mi, W, K, N, NP, WT);
        transpose_item(W, K, N, WT, scr, r, NP / 32, lane);
    }
    float* cosT = (float*)(p.ws + WS_ROT); float* sinT = cosT + T * 64;
    for (int idx = blockIdx.x * NTHREADS + tid; idx < T * 64; idx += G * NTHREADS) {
        const int pos = idx >> 6, i = idx & 63;
        const float invf = (float)exp(-(double)i * (9.210340371976184 / 64.0));
        const float angf = (float)pos * invf;
        double rv = (double)angf * 0.15915494309189535; rv -= floor(rv);
        const float rf = (float)rv;
        cosT[idx] = __builtin_amdgcn_cosf(rf); sinT[idx] = __builtin_amdgcn_sinf(rf);
    }
    norm_phase(nullptr, nullptr, p.x, nullptr, nullptr, p.norm_g, (bf16_t*)(p.ws + WS_U), gw, NGW, lane);
}

constexpr int SW_KS = 72, SW_VS = 280, SW_PS = 168;
constexpr int SW_K_OFF = 0, SW_V_OFF = 272 * SW_KS * 2, SW_P_OFF = SW_V_OFF + 64 * SW_VS * 2;
static_assert(SW_P_OFF + 8 * 16 * SW_PS * 2 <= LDS_BYTES, "swa lds");
__device__ __forceinline__ void swa_unit(LAS unsigned char* lds, const bf16_t* Z, bf16_t* MIX, const float* sinks, int b, int kvh, int n, int tid, int w, int lane) {
    LAS bf16_t* Ks = (LAS bf16_t*)(lds + SW_K_OFF); LAS bf16_t* VTs = (LAS bf16_t*)(lds + SW_V_OFF); LAS bf16_t* Pw = (LAS bf16_t*)(lds + SW_P_OFF) + w * 16 * SW_PS;
    const int fr = lane & 15, fq = lane >> 4;
    const size_t rowb = (size_t)b * T;
    for (int idx = tid; idx < 272 * 8; idx += NTHREADS) { const int jj = idx >> 3, c = idx & 7; const int t = n * 128 - 128 + jj;
        u32x4 v = (u32x4){0u, 0u, 0u, 0u};
        if (jj < 256 && t >= 0) v = *(const u32x4*)(Z + (rowb + t) * EV_IN + 2560 + kvh * 64 + c * 8);
        *(LAS u32x4*)(Ks + jj * SW_KS + c * 8) = v; }
    { const int jj = tid & 255, eh = tid >> 8; const int t = n * 128 - 128 + jj;
#pragma unroll
        for (int c = 0; c < 4; ++c) { u32x4 v = (u32x4){0u, 0u, 0u, 0u};
            if (t >= 0) v = *(const u32x4*)(Z + (rowb + t) * EV_IN + 2688 + kvh * 64 + eh * 32 + c * 8);
            LAS bf16_t* dst = VTs + (eh * 32 + c * 8) * SW_VS + jj;
            dst[0 * SW_VS] = (bf16_t)(v.x & 0xffffu); dst[1 * SW_VS] = (bf16_t)(v.x >> 16); dst[2 * SW_VS] = (bf16_t)(v.y & 0xffffu); dst[3 * SW_VS] = (bf16_t)(v.y >> 16);
            dst[4 * SW_VS] = (bf16_t)(v.z & 0xffffu); dst[5 * SW_VS] = (bf16_t)(v.z >> 16); dst[6 * SW_VS] = (bf16_t)(v.w & 0xffffu); dst[7 * SW_VS] = (bf16_t)(v.w >> 16); } }
    for (int idx = tid; idx < 64 * 24; idx += NTHREADS) VTs[(idx / 24) * SW_VS + 256 + (idx % 24)] = 0;
    __syncthreads();
    const int i = 16 * w + fr; const size_t qrow = rowb + n * 128 + i;
#pragma unroll 1
    for (int g = 0; g < 4; ++g) {
        const int hq = kvh * 4 + g; const float sink = sinks[hq];
        bf16x8 aq[2];
#pragma unroll
        for (int ks = 0; ks < 2; ++ks) aq[ks] = *(const bf16x8*)(Z + qrow * EV_IN + 2048 + hq * 64 + ks * 32 + 8 * fq);
        f32x4 s[10];
#pragma unroll
        for (int nt = 0; nt < 10; ++nt) { s[nt] = (f32x4){0.f, 0.f, 0.f, 0.f};
#pragma unroll
            for (int ks = 0; ks < 2; ++ks) { const bf16x8 bk = *(const LAS bf16x8*)(Ks + (16 * (w + nt) + fr) * SW_KS + ks * 32 + 8 * fq); s[nt] = MFMA16(bk, aq[ks], s[nt]); } }
        float mx = sink;
#pragma unroll
        for (int nt = 0; nt < 10; ++nt)
#pragma unroll
            for (int c = 0; c < 4; ++c) { const int jj = 16 * (w + nt) + 4 * fq + c; const bool ok = (jj > i) && (jj <= i + 128) && (n > 0 || jj >= 128);
                const float v = ok ? s[nt][c] * 0.125f : -1e30f; s[nt][c] = v; mx = fmaxf(mx, v); }
        mx = fmaxf(mx, __shfl_xor(mx, 16)); mx = fmaxf(mx, __shfl_xor(mx, 32));
        float sum = 0.f;
#pragma unroll
        for (int nt = 0; nt < 10; ++nt) {
#pragma unroll
            for (int c = 0; c < 4; ++c) { const float pv = __expf(s[nt][c] - mx); s[nt][c] = pv; sum += pv; }
            u32x2 wv; wv.x = pk2(s[nt][0], s[nt][1]); wv.y = pk2(s[nt][2], s[nt][3]);
            *(LAS u32x2*)(Pw + fr * SW_PS + 16 * nt + 4 * fq) = wv; }
        sum += __shfl_xor(sum, 16); sum += __shfl_xor(sum, 32);
        sum += __expf(sink - mx);
        LDS_WAIT();
        f32x4 o[4];
#pragma unroll
        for (int nt = 0; nt < 4; ++nt) o[nt] = (f32x4){0.f, 0.f, 0.f, 0.f};
#pragma unroll
        for (int ks = 0; ks < 5; ++ks) { const bf16x8 ap = *(const LAS bf16x8*)(Pw + fr * SW_PS + ks * 32 + 8 * fq);
#pragma unroll
            for (int nt = 0; nt < 4; ++nt) { const bf16x8 bv = *(const LAS bf16x8*)(VTs + (16 * nt + fr) * SW_VS + 16 * w + ks * 32 + 8 * fq); o[nt] = MFMA16(bv, ap, o[nt]); } }
        LDS_WAIT();
        const float inv = 1.f / sum;
#pragma unroll
        for (int nt = 0; nt < 4; ++nt) { u32x2 wv; wv.x = pk2(o[nt][0] * inv, o[nt][1] * inv); wv.y = pk2(o[nt][2] * inv, o[nt][3] * inv);
            *(u32x2*)(MIX + qrow * D + 512 + hq * 64 + 16 * nt + 4 * fq) = wv; }
    }
    __syncthreads();
}

constexpr int LA_S = 136;
constexpr int LA_R0 = 0, LA_R1 = 128 * LA_S * 2, LA_X = 2 * 128 * LA_S * 2;
static_assert(LA_X + 256 * LA_S * 2 <= LDS_BYTES && 128 * 129 * 4 <= 256 * LA_S * 2, "la lds");

template <bool GLA> struct LaC { static constexpr int DV = GLA ? 256 : 128, LD = GLA ? OD_LD : EV_IN, GOFF = GLA ? 2048 : 1536; };

__device__ __forceinline__ void gla_compute_b(LAS unsigned char* lds, int xoff, const bf16_t* Z, size_t row0, int h, const float* Wg, const float* bias, int tid) {
    LAS float* Xb = (LAS float*)(lds + xoff); LAS float* al = (LAS float*)(lds + LA_R0); LAS float* tot = al + 128 * 16;
#ifdef DBG_NOB
    { const int d = tid & 127, jq = tid >> 7; for (int jj = 0; jj < 32; ++jj) { const int j = jq * 32 + jj; Xb[j * 129 + d] = -0.05f * (float)(j + 1) * (1.f + (float)d * (1.f / 128.f)); } __syncthreads(); return; }
#endif
    if (tid < 256) { const int j = tid >> 1, c = tid & 1; const u32x4 v = *(const u32x4*)(Z + (row0 + j) * OD_LD + 3072 + c * 8); float f[8]; unpack8(v, f);
        *(LAS f32x4*)(al + j * 16 + c * 8) = (f32x4){f[0], f[1], f[2], f[3]}; *(LAS f32x4*)(al + j * 16 + c * 8 + 4) = (f32x4){f[4], f[5], f[6], f[7]}; }
    __syncthreads();
    const int d = tid & 127, jq = tid >> 7;
    float wg[16];
#pragma unroll
    for (int r = 0; r < 16; ++r) wg[r] = Wg[r * 512 + h * 128 + d];
    const float bs = bias[h * 128 + d];
    float s = 0.f;
#pragma unroll 4
    for (int jj = 0; jj < 32; ++jj) { const int j = jq * 32 + jj; float x = bs;
#pragma unroll
        for (int r4 = 0; r4 < 4; ++r4) { const f32x4 a = *(const LAS f32x4*)(al + j * 16 + r4 * 4); x += a[0] * wg[r4 * 4 + 0] + a[1] * wg[r4 * 4 + 1] + a[2] * wg[r4 * 4 + 2] + a[3] * wg[r4 * 4 + 3]; }
        const float lg = (fminf(x, 0.f) - __logf(1.f + __expf(-fabsf(x)))) * (1.f / 16.f);
        s += lg; Xb[j * 129 + d] = s; }
    tot[jq * 128 + d] = s;
    __syncthreads();
    float off = 0.f;
#pragma unroll
    for (int q = 0; q < 3; ++q) if (q < jq) off += tot[q * 128 + d];
    if (jq > 0) {
#pragma unroll 4
        for (int jj = 0; jj < 32; ++jj) Xb[(jq * 32 + jj) * 129 + d] += off; }
    __syncthreads();
}

template <bool ROT> __device__ __forceinline__ void load_rot8(const bf16_t* src, const float* cosr, const float* sinr, float (&r1)[8], float (&r2)[8]) {
    const u32x4 a = *(const u32x4*)src, b = *(const u32x4*)(src + 64); unpack8(a, r1); unpack8(b, r2);
    if (ROT) { const f32x4 c0 = *(const f32x4*)cosr, c1 = *(const f32x4*)(cosr + 4), s0 = *(const f32x4*)sinr, s1 = *(const f32x4*)(sinr + 4);
#pragma unroll
        for (int e = 0; e < 8; ++e) { const float cs = e < 4 ? c0[e & 3] : c1[e & 3], sn = e < 4 ? s0[e & 3] : s1[e & 3]; const float t1 = r1[e] * cs - r2[e] * sn, t2 = r1[e] * sn + r2[e] * cs; r1[e] = t1; r2[e] = t2; } }
}

template <bool GLA, int NR> __device__ __forceinline__ void la_stage_vt(LAS unsigned char* lds, int xoff, const bf16_t* Z, size_t row0, int h, int e0, int tid) {
    constexpr int DV = LaC<GLA>::DV, LD = LaC<GLA>::LD;
    LAS bf16_t* VT = (LAS bf16_t*)(lds + xoff);
    const int j = tid & 127, eq = tid >> 7; const bf16_t* vrow = Z + (row0 + j) * LD + 1024 + h * DV + e0 + eq * (NR / 4);
#pragma unroll
    for (int c = 0; c < NR / 32; ++c) { const u32x4 v = *(const u32x4*)(vrow + c * 8); LAS bf16_t* dst = VT + (eq * (NR / 4) + c * 8) * LA_S + j;
        dst[0 * LA_S] = (bf16_t)(v.x & 0xffffu); dst[1 * LA_S] = (bf16_t)(v.x >> 16); dst[2 * LA_S] = (bf16_t)(v.y & 0xffffu); dst[3 * LA_S] = (bf16_t)(v.y >> 16);
        dst[4 * LA_S] = (bf16_t)(v.z & 0xffffu); dst[5 * LA_S] = (bf16_t)(v.z >> 16); dst[6 * LA_S] = (bf16_t)(v.w & 0xffffu); dst[7 * LA_S] = (bf16_t)(v.w >> 16); }
}

template <bool GLA> __device__ __forceinline__ void la1_unit(LAS unsigned char* lds, const Params& p, int li, int u, int half, int tid, int w, int lane) {
    constexpr int DV = LaC<GLA>::DV, LD = LaC<GLA>::LD, MT = DV / 128;
    const bf16_t* Z = (const bf16_t*)(p.ws + WS_Z); bf16_t* ST = (bf16_t*)(p.ws + WS_ST); float* DEC = (float*)(p.ws + WS_DEC);
    const float* cosT = (const float*)(p.ws + WS_ROT); const float* sinT = cosT + T * 64;
    const int b = u >> 7, h = (u >> 5) & 3, n = u & 31; const size_t row0 = (size_t)b * T + n * 128;
    const int fr = lane & 15, fq = lane >> 4;
    constexpr int LA1X = LA_R1;
    LAS bf16_t* KdT = (LAS bf16_t*)(lds + LA_R0); LAS float* Xb = (LAS float*)(lds + LA1X); LAS bf16_t* VT = (LAS bf16_t*)(lds + LA1X);
    if (GLA) gla_compute_b(lds, LA1X, Z, row0, h, p.od_w_gate_up + (size_t)li * 16 * 512, p.od_gate_bias + li * 512, tid);
    const float lgam = GLA ? 0.f : log1pf(-exp2f(-5.f - (float)h));
    {   const int j = tid & 127, pq = tid >> 7, pos = n * 128 + j; const bf16_t* krow = Z + (row0 + j) * LD + 512 + h * 128;
#pragma unroll
        for (int c = 0; c < 2; ++c) { const int i0 = pq * 16 + c * 8; float r1[8], r2[8];
#ifdef DBG_NOROT
            load_rot8<false>(krow + i0, cosT + pos * 64 + i0, sinT + pos * 64 + i0, r1, r2);
#else
            load_rot8<!GLA>(krow + i0, cosT + pos * 64 + i0, sinT + pos * 64 + i0, r1, r2);
#endif
#pragma unroll
            for (int e = 0; e < 8; ++e) { const int d1 = i0 + e, d2 = d1 + 64; float f1, f2;
                if (GLA) { f1 = __expf(Xb[127 * 129 + d1] - Xb[j * 129 + d1]); f2 = __expf(Xb[127 * 129 + d2] - Xb[j * 129 + d2]); } else { f1 = f2 = __expf(lgam * (float)(127 - j)); }
                KdT[d1 * LA_S + j] = f2bf(r1[e] * f1); KdT[d2 * LA_S + j] = f2bf(r2[e] * f2); } }
#ifndef DBG_NODEC
        if (GLA && w < 2 && half == 0) DEC[(size_t)u * 128 + (tid & 127)] = __expf(Xb[127 * 129 + (tid & 127)]);
#endif
    }
    __syncthreads();
    la_stage_vt<GLA, DV>(lds, LA1X, Z, row0, h, 0, tid);
    __syncthreads();
    f32x4 acc[MT][8];
#pragma unroll
    for (int mt = 0; mt < MT; ++mt)
#pragma unroll
        for (int nt = 0; nt < 8; ++nt) acc[mt][nt] = (f32x4){0.f, 0.f, 0.f, 0.f};
#pragma unroll
    for (int ks = 0; ks < 4; ++ks) { bf16x8 a[MT];
#pragma unroll
        for (int mt = 0; mt < MT; ++mt) a[mt] = *(const LAS bf16x8*)(VT + (w * 16 * MT + 16 * mt + fr) * LA_S + ks * 32 + 8 * fq);
#pragma unroll
        for (int nt = 0; nt < 8; ++nt) { bf16x8 bb = *(const LAS bf16x8*)(KdT + (16 * nt + fr) * LA_S + ks * 32 + 8 * fq);
#ifdef DBG_ONEK
            bb = (bf16x8){0x3f80, 0x3f80, 0x3f80, 0x3f80, 0x3f80, 0x3f80, 0x3f80, 0x3f80};
#endif
#ifdef DBG_ONEV
            a[0] = (bf16x8){0x3f80, 0x3f80, 0x3f80, 0x3f80, 0x3f80, 0x3f80, 0x3f80, 0x3f80};
#endif
#pragma unroll
            for (int mt = 0; mt < MT; ++mt) acc[mt][nt] = MFMA16(bb, a[mt], acc[mt][nt]); } }
    bf16_t* stu = ST + (size_t)u * DV * 128 + (size_t)half * 128 * 128;
#pragma unroll
    for (int mt = 0; mt < MT; ++mt)
#pragma unroll
        for (int nt = 0; nt < 8; ++nt) { u32x2 wv; wv.x = pk2(acc[mt][nt][0], acc[mt][nt][1]); wv.y = pk2(acc[mt][nt][2], acc[mt][nt][3]);
#ifdef DBG_CONSTST
            wv.x = pk2((float)(u & 63), (float)nt); wv.y = pk2((float)fr, (float)fq);
#endif
            *(u32x2*)(stu + (size_t)(w * 16 * MT + 16 * mt + fr) * 128 + 16 * nt + 4 * fq) = wv; }
    __syncthreads();
}

template <bool GLA> __device__ __forceinline__ void la2_phase(const Params& p, int tid, int bx, int rk, int NL) {
    constexpr int DV = LaC<GLA>::DV;
    bf16_t* ST = (bf16_t*)(p.ws + WS_ST); const float* DEC = (const float*)(p.ws + WS_DEC);
    const int totl = 4 * DV * 16;
    for (int itl = rk * NTHREADS + tid; itl < totl; itl += NL * NTHREADS) { const int it = bx * totl + itl;
        const int dg = it & 15, e = (it >> 4) % DV, bh = it / (16 * DV);
        const float cdec = GLA ? 0.f : __expf(128.f * log1pf(-exp2f(-5.f - (float)(bh & 3))));
        float S[8];
#pragma unroll
        for (int k = 0; k < 8; ++k) S[k] = 0.f;
#pragma unroll 8
        for (int n = 0; n < 32; ++n) { const size_t u = (size_t)bh * 32 + n; u32x4* ptr = (u32x4*)(ST + (u * DV + e) * 128 + dg * 8);
            const u32x4 kvw = *ptr; float kv[8]; unpack8(kvw, kv);
            float dc[8];
            if (GLA) { const f32x4 d0 = *(const f32x4*)(DEC + u * 128 + dg * 8), d1 = *(const f32x4*)(DEC + u * 128 + dg * 8 + 4);
                dc[0] = d0[0]; dc[1] = d0[1]; dc[2] = d0[2]; dc[3] = d0[3]; dc[4] = d1[0]; dc[5] = d1[1]; dc[6] = d1[2]; dc[7] = d1[3]; }
            else {
#pragma unroll
                for (int k = 0; k < 8; ++k) dc[k] = cdec; }
            *ptr = pack8(S);
#pragma unroll
            for (int k = 0; k < 8; ++k) S[k] = dc[k] * S[k] + kv[k]; }
    }
}

template <bool GLA> __device__ __forceinline__ void la3_unit(LAS unsigned char* lds, const Params& p, int li, int u, int tid, int w, int lane) {
    constexpr int DV = LaC<GLA>::DV, LD = LaC<GLA>::LD, GOFF = LaC<GLA>::GOFF, NT = DV / 16;
    const bf16_t* Z = (const bf16_t*)(p.ws + WS_Z); const bf16_t* ST = (const bf16_t*)(p.ws + WS_ST); bf16_t* MIX = (bf16_t*)(p.ws + WS_MIX);
    const float* cosT = (const float*)(p.ws + WS_ROT); const float* sinT = cosT + T * 64;
    const float* ng = GLA ? p.od_norm_g + li * 1024 : p.ev_ret_norm_g + li * 512;
    const int b = u >> 7, h = (u >> 5) & 3, n = u & 31; const size_t row0 = (size_t)b * T + n * 128;
    const int fr = lane & 15, fq = lane >> 4;
    LAS bf16_t* Qin = (LAS bf16_t*)(lds + LA_R0); LAS bf16_t* Kin = (LAS bf16_t*)(lds + LA_R1); LAS float* Xb = (LAS float*)(lds + LA_X); LAS bf16_t* Xs = (LAS bf16_t*)(lds + LA_X);
    if (GLA) gla_compute_b(lds, LA_X, Z, row0, h, p.od_w_gate_up + (size_t)li * 16 * 512, p.od_gate_bias + li * 512, tid);
    const float lgam = GLA ? 0.f : log1pf(-exp2f(-5.f - (float)h));
    const float scale = 0.08838834764831845f;
    {   const int j = tid >> 2, pq = tid & 3, pos = n * 128 + j; const bf16_t* qrow = Z + (row0 + j) * LD + h * 128; const bf16_t* krow = qrow + 512;
#pragma unroll
        for (int c = 0; c < 2; ++c) { const int i0 = pq * 8 + c * 32; float q1[8], q2[8], k1[8], k2[8];
            load_rot8<!GLA>(qrow + i0, cosT + pos * 64 + i0, sinT + pos * 64 + i0, q1, q2);
            load_rot8<!GLA>(krow + i0, cosT + pos * 64 + i0, sinT + pos * 64 + i0, k1, k2);
#pragma unroll
            for (int e = 0; e < 8; ++e) { float b1, b2;
                if (GLA) { b1 = Xb[j * 129 + i0 + e]; b2 = Xb[j * 129 + 64 + i0 + e]; } else { b1 = b2 = lgam * (float)(j + 1); }
                q1[e] *= scale * __expf(b1); q2[e] *= scale * __expf(b2); k1[e] *= __expf(-b1); k2[e] *= __expf(-b2); }
            *(LAS u32x4*)(Qin + j * LA_S + i0) = pack8(q1); *(LAS u32x4*)(Qin + j * LA_S + 64 + i0) = pack8(q2);
            *(LAS u32x4*)(Kin + j * LA_S + i0) = pack8(k1); *(LAS u32x4*)(Kin + j * LA_S + 64 + i0) = pack8(k2); }
    }
    __syncthreads();
    {   const bf16_t* stu = ST + (size_t)u * DV * 128;
        u32x4 sv[DV / 32];
#pragma unroll
        for (int i = 0; i < DV / 32; ++i) { const int idx = tid + i * NTHREADS; sv[i] = *(const u32x4*)(stu + (size_t)(idx >> 4) * 128 + (idx & 15) * 8); }
#pragma unroll
        for (int i = 0; i < DV / 32; ++i) { const int idx = tid + i * NTHREADS; *(LAS u32x4*)(Xs + (idx >> 4) * LA_S + (idx & 15) * 8) = sv[i]; } }
    __syncthreads();
    f32x4 acco[NT], accA[8];
#pragma unroll
    for (int nt = 0; nt < NT; ++nt) acco[nt] = (f32x4){0.f, 0.f, 0.f, 0.f};
#pragma unroll
    for (int nt = 0; nt < 8; ++nt) accA[nt] = (f32x4){0.f, 0.f, 0.f, 0.f};
#pragma unroll
    for (int ks = 0; ks < 4; ++ks) { const bf16x8 a = *(const LAS bf16x8*)(Qin + (16 * w + fr) * LA_S + ks * 32 + 8 * fq);
#pragma unroll
        for (int nt = 0; nt < NT; ++nt) { const bf16x8 bb = *(const LAS bf16x8*)(Xs + (16 * nt + fr) * LA_S + ks * 32 + 8 * fq); acco[nt] = MFMA16(bb, a, acco[nt]); }
#pragma unroll
        for (int nt = 0; nt < 8; ++nt) if (nt <= w) { const bf16x8 bb = *(const LAS bf16x8*)(Kin + (16 * nt + fr) * LA_S + ks * 32 + 8 * fq); accA[nt] = MFMA16(bb, a, accA[nt]); } }
    {   const int i = 16 * w + fr;
#pragma unroll
        for (int nt = 0; nt < 8; ++nt)
#pragma unroll
            for (int c = 0; c < 4; ++c) { const int j = 16 * nt + 4 * fq + c; if (j > i) accA[nt][c] = 0.f; } }
    __syncthreads();
#pragma unroll
    for (int nt = 0; nt < 8; ++nt) { u32x2 wv; wv.x = pk2(accA[nt][0], accA[nt][1]); wv.y = pk2(accA[nt][2], accA[nt][3]); *(LAS u32x2*)(Qin + (16 * w + fr) * LA_S + 16 * nt + 4 * fq) = wv; }
    la_stage_vt<GLA, LaC<GLA>::DV>(lds, LA_X, Z, row0, h, 0, tid);
    __syncthreads();
#pragma unroll
    for (int ks = 0; ks < 4; ++ks) if (2 * ks <= w) { const bf16x8 a = *(const LAS bf16x8*)(Qin + (16 * w + fr) * LA_S + ks * 32 + 8 * fq);
#pragma unroll
        for (int nt = 0; nt < NT; ++nt) { const bf16x8 bb = *(const LAS bf16x8*)(Xs + (16 * nt + fr) * LA_S + ks * 32 + 8 * fq); acco[nt] = MFMA16(bb, a, acco[nt]); } }
    float ss = 0.f;
#pragma unroll
    for (int nt = 0; nt < NT; ++nt) ss += (acco[nt][0] * acco[nt][0] + acco[nt][1] * acco[nt][1]) + (acco[nt][2] * acco[nt][2] + acco[nt][3] * acco[nt][3]);
    ss += __shfl_xor(ss, 16); ss += __shfl_xor(ss, 32);
    const float r = rsqrtf(ss * (1.f / DV) + EPS);
    const size_t orow = row0 + 16 * w + fr;
#pragma unroll
    for (int nt = 0; nt < NT; ++nt) { const int e = 16 * nt + 4 * fq; const f32x4 g4 = *(const f32x4*)(ng + h * DV + e);
        const u32x2 gw2 = *(const u32x2*)(Z + orow * LD + GOFF + h * DV + e);
        const float g0 = lo_bf(gw2.x), g1 = hi_bf(gw2.x), g2 = lo_bf(gw2.y), g3 = hi_bf(gw2.y);
        const float v0 = acco[nt][0] * r * g4[0] * (g0 / (1.f + __expf(-g0))), v1 = acco[nt][1] * r * g4[1] * (g1 / (1.f + __expf(-g1)));
        const float v2 = acco[nt][2] * r * g4[2] * (g2 / (1.f + __expf(-g2))), v3 = acco[nt][3] * r * g4[3] * (g3 / (1.f + __expf(-g3)));
        u32x2 wv; wv.x = pk2(v0, v1); wv.y = pk2(v2, v3);
        *(u32x2*)(MIX + orow * D + h * DV + e) = wv; }
    __syncthreads();
}

__device__ __forceinline__ float block_sum(float v, LAS float* red, int tid) {
    v = wave_sum(v); __syncthreads(); if ((tid & 63) == 0) red[tid >> 6] = v; __syncthreads();
    float t = 0.f;
#pragma unroll
    for (int i = 0; i < NWAVES; ++i) t += red[i];
    return t;
}
template <bool ADD> __device__ __forceinline__ void t0_rmsnorm_(const LAS float* in, const float* g, LAS float* dst, LAS float* red, int tid) {
    const float a = in[tid], b = in[tid + 512]; const float r = rsqrtf(block_sum(a * a + b * b, red, tid) * (1.f / D) + EPS);
    if (ADD) { dst[tid] += a * r * g[tid]; dst[tid + 512] += b * r * g[tid + 512]; } else { dst[tid] = a * r * g[tid]; dst[tid + 512] = b * r * g[tid + 512]; }
    __syncthreads();
}
__device__ __forceinline__ void t0_gemv(const float* W, int K, int N, const LAS float* in, LAS float* outv, int act, int tid) {
    for (int n = tid; n < N; n += NTHREADS) { float acc[8];
#pragma unroll
        for (int i = 0; i < 8; ++i) acc[i] = 0.f;
        for (int k = 0; k < K; k += 8) {
#pragma unroll
            for (int i = 0; i < 8; ++i) acc[i] += in[k + i] * W[(size_t)(k + i) * N + n]; }
        float a = ((acc[0] + acc[1]) + (acc[2] + acc[3])) + ((acc[4] + acc[5]) + (acc[6] + acc[7]));
        if (act == 2) { a = fmaxf(a, 0.f); a = a * a; }
        outv[n] = a; }
    __syncthreads();
}
constexpr size_t WS_T0 = WS_CTL + 65536;
constexpr int T0_H = 0, T0_U = 8192, T0_Z = 16384, T0_MIX = 49152, T0_Y = 57344;
__device__ __forceinline__ void t0_skinny(const float* W, int K, int N, const float* in, int ldi, float* outp, int ldo, int act, LAS unsigned char* lds, int tid) {
    const int CW = N >= 2048 ? 16 : 4, NKP = NTHREADS / CW, KS = K / NKP;
    const int c = tid % CW, kp = tid / CW, col = blockIdx.x * CW + c;
    if (blockIdx.x * CW >= N) return;
    float acc[8];
#pragma unroll
    for (int r = 0; r < 8; ++r) acc[r] = 0.f;
    if (col < N) {
        for (int k = kp * KS; k < (kp + 1) * KS; k += 4) { float w[4];
#pragma unroll
            for (int i = 0; i < 4; ++i) w[i] = W[(size_t)(k + i) * N + col];
#pragma unroll
            for (int r = 0; r < 8; ++r) { const f32x4 x = *(const f32x4*)(in + (size_t)r * ldi + k); acc[r] += x[0] * w[0] + x[1] * w[1] + x[2] * w[2] + x[3] * w[3]; } } }
#pragma unroll
    for (int r = 0; r < 8; ++r) { float a = acc[r]; for (int o = CW; o < 64; o <<= 1) a += __shfl_xor(a, o); acc[r] = a; }
    LAS float* part = (LAS float*)lds;
    if ((tid & 63) < CW) {
#pragma unroll
        for (int r = 0; r < 8; ++r) part[((tid >> 6) * CW + c) * 8 + r] = acc[r]; }
    __syncthreads();
    if (tid < CW * 8) { const int cc = tid >> 3, r = tid & 7; float a = 0.f;
#pragma unroll
        for (int q = 0; q < NWAVES; ++q) a += part[(q * CW + cc) * 8 + r];
        if (act == 2) { a = fmaxf(a, 0.f); a = a * a; }
        const int n = blockIdx.x * CW + cc; if (n < N) outp[(size_t)r * ldo + n] = a; }
    __syncthreads();
}
__device__ __forceinline__ void t0_load(LAS float* dst, const float* src, int n, int tid) { for (int i = tid; i < n; i += NTHREADS) dst[i] = src[i]; __syncthreads(); }
__device__ __forceinline__ void t0_store(float* dst, const LAS float* src, int n, int tid) { for (int i = tid; i < n; i += NTHREADS) dst[i] = src[i]; __syncthreads(); }

__device__ __forceinline__ void t0_mix_even(const Params& p, int li, const LAS float* z, LAS float* mix, LAS float* sc, int tid) {
            if (tid < 4 * 64) { const int hh = tid >> 6, l = tid & 63; float a = z[hh * 128 + l] * z[512 + hh * 128 + l] + z[hh * 128 + 64 + l] * z[512 + hh * 128 + 64 + l];
                float v2 = z[1024 + hh * 128 + l] * z[1024 + hh * 128 + l] + z[1024 + hh * 128 + 64 + l] * z[1024 + hh * 128 + 64 + l];
                a = wave_sum(a) * 0.08838834764831845f; v2 = wave_sum(v2); if (l == 0) { sc[2 * hh] = a; sc[2 * hh + 1] = a * a * v2 * (1.f / 128.f); } }
            __syncthreads();
            { const int hh = tid >> 7, e = tid; const float sv = sc[2 * hh], r = rsqrtf(sc[2 * hh + 1] + EPS), gt = z[1536 + e];
              mix[e] = sv * z[1024 + e] * r * p.ev_ret_norm_g[li * 512 + e] * (gt / (1.f + expf(-gt))); }
            { const int hq = tid >> 6, l = tid & 63, kv = hq >> 2; float a = wave_sum(z[2048 + hq * 64 + l] * z[2560 + kv * 64 + l]) * 0.125f;
              const float sink = p.ev_sinks[li * 8 + hq], m = fmaxf(a, sink), pe = expf(a - m), den = pe + expf(sink - m);
              mix[512 + hq * 64 + l] = (pe / den) * z[2688 + kv * 64 + l]; }
            __syncthreads();
}
__device__ __forceinline__ void t0_mix_odd(const Params& p, int li, const LAS float* z, LAS float* mix, LAS float* sc, int tid) {
            if (tid < 4 * 64) { const int hh = tid >> 6, l = tid & 63; float a = z[hh * 128 + l] * z[512 + hh * 128 + l] + z[hh * 128 + 64 + l] * z[512 + hh * 128 + 64 + l];
                float v2 = 0.f;
#pragma unroll
                for (int q = 0; q < 4; ++q) { const float vv = z[1024 + hh * 256 + q * 64 + l]; v2 += vv * vv; }
                a = wave_sum(a) * 0.08838834764831845f; v2 = wave_sum(v2); if (l == 0) { sc[2 * hh] = a; sc[2 * hh + 1] = a * a * v2 * (1.f / 256.f); } }
            __syncthreads();
#pragma unroll
            for (int q = 0; q < 2; ++q) { const int e = tid + 512 * q, hh = e >> 8; const float sv = sc[2 * hh], r = rsqrtf(sc[2 * hh + 1] + EPS), gt = z[2048 + e];
                mix[e] = sv * z[1024 + e] * r * p.od_norm_g[li * 1024 + e] * (gt / (1.f + expf(-gt))); }
            __syncthreads();
}
__device__ __forceinline__ void t0_path(const Params& p, LAS unsigned char* lds, int b, int tid, int nlayers = DEPTH) {
    LAS float* h = (LAS float*)lds; LAS float* u = h + 1024; LAS float* z = u + 1024; LAS float* mix = z + 4096; LAS float* y = mix + 1024; LAS float* red = y + 1024; LAS float* sc = red + 16;
    h[tid] = p.x[(size_t)b * T * D + tid]; h[tid + 512] = p.x[(size_t)b * T * D + tid + 512];
    __syncthreads();
#pragma unroll 1
    for (int layer = 0; layer < nlayers; ++layer) { const int li = layer >> 1; const float* ng = p.norm_g + (size_t)layer * 4 * D;
        t0_rmsnorm_<false>(h, ng, u, red, tid);
        if (!(layer & 1)) {
            t0_gemv(p.ev_w_in + (size_t)li * 1024 * EV_IN, 1024, EV_IN, u, z, 0, tid);
            t0_mix_even(p, li, z, mix, sc, tid);
            t0_gemv(p.ev_w_out + (size_t)li * 1024 * 1024, 1024, 1024, mix, y, 0, tid);
        } else {
            t0_gemv(p.od_w_in + (size_t)li * 1024 * OD_IN, 1024, OD_IN, u, z, 0, tid);
            t0_mix_odd(p, li, z, mix, sc, tid);
            t0_gemv(p.od_w_out + (size_t)li * 1024 * 1024, 1024, 1024, mix, y, 0, tid);
        }
        t0_rmsnorm_<true>(y, ng + D, h, red, tid);
        t0_rmsnorm_<false>(h, ng + 2 * D, u, red, tid);
        t0_gemv(p.w_up + (size_t)layer * 1024 * FF, 1024, FF, u, z, 2, tid);
        t0_gemv(p.w_down + (size_t)layer * FF * 1024, FF, 1024, z, y, 0, tid);
        t0_rmsnorm_<true>(y, ng + 3 * D, h, red, tid);
    }
#ifdef DBG_T0CMP
    { const float d0 = fabsf(p.out[(size_t)b * T * D + tid] - h[tid]), d1 = fabsf(p.out[(size_t)b * T * D + tid + 512] - h[tid + 512]);
      if (d0 > DBG_T0CMP || d1 > DBG_T0CMP) p.out[(size_t)b * T * D + tid] = __builtin_nanf(""); }
#else
    p.out[(size_t)b * T * D + tid] = h[tid]; p.out[(size_t)b * T * D + tid + 512] = h[tid + 512];
#endif
}

struct XcdOrder {
    int nN, nu, NL, bx, rk, blk;
    __device__ void init(int N, int G, int c) { nN = N / pg8::BM; nu = 16 * nN; NL = G >> 3; bx = c & 7; rk = c >> 3; blk = (NL == 32) ? 1 : 0; }
    __device__ bool next(int i, pg8::Unit& u) const {
        if (blk) { if (nN == 13 && i >= 6) { if (i > 6 || rk >= 16) return false; u.pm = bx * 16 + rk; u.pn = 12; return true; }
            const int pn = 4 * (i >> 1) + (rk >> 3); if (pn >= nN) return false; u.pm = bx * 16 + 8 * (i & 1) + (rk & 7); u.pn = pn; return true; }
        const int L = i * NL + rk; if (L >= nu) return false; u.pm = bx * 16 + (L & 15); u.pn = L >> 4; return true; }
    __device__ __forceinline__ void a_ready(const pg8::Unit&) const {}
    __device__ __forceinline__ void done(const pg8::Unit&) const {}
};
#ifndef PG8_ALIGN_OPT
#define PG8_ALIGN_OPT true
#endif
#ifndef PG8_SP2_OPT
#define PG8_SP2_OPT true
#endif
#define GAS __attribute__((address_space(1)))
#define XB_TMO      128
#define XB_XCNT(j)  (256  + 64 * (j))
#define XB_XSUB(j)  (1280 + 64 * (j))
#define XB_XGEN(j)  (2304 + 64 * (j))
#define XB_TOP      3328
#define XB_TOPGEN   3392
#define XCD_BAR_WORDS 3456
#define XB_SPIN_CAP (1u << 18)

__device__ __forceinline__ unsigned xb_ld(unsigned* p)              { return __hip_atomic_load(p, __ATOMIC_RELAXED, __HIP_MEMORY_SCOPE_AGENT); }
__device__ __forceinline__ unsigned xb_add(unsigned* p, unsigned v) { return __hip_atomic_fetch_add(p, v, __ATOMIC_RELAXED, __HIP_MEMORY_SCOPE_AGENT); }
__device__ __forceinline__ unsigned xb_xcc_id() { return (unsigned)__builtin_amdgcn_s_getreg((3 << 11) | 20) & 0xFu; }
#define XB_SPIN(cond, bar) do { unsigned _sp = 0; while (cond) { __builtin_amdgcn_s_sleep(1); \
    if ((++_sp & 255u) == 0u) { if (xb_ld(&(bar)[XB_TMO])) break; if (_sp > XB_SPIN_CAP) { atomicAdd(&(bar)[XB_TMO], 1u); break; } } } } while (0)

struct XcdBarrier {
    unsigned* bar; unsigned x;
    volatile LAS unsigned* st;
};

__device__ __forceinline__ XcdBarrier xcd_barrier_post(unsigned* bar, volatile LAS unsigned* st) {
    XcdBarrier b; b.bar = bar; b.x = xb_xcc_id(); b.st = st;
    if (threadIdx.x == 0) (void)xb_add(&bar[XB_XCNT(b.x)], 1u);
    return b;
}
__device__ __forceinline__ void xcd_barrier_complete(unsigned* bar, unsigned x, unsigned& nloc, unsigned& nx) {
    const unsigned G = gridDim.x * gridDim.y * gridDim.z;
    unsigned sum, cnt, mine, sp = 0u;
    for (;;) {
        sum = 0u; cnt = 0u; mine = 0u;
#pragma unroll
        for (unsigned j = 0; j < 16; ++j) { const unsigned c = xb_ld(&bar[XB_XCNT(j)]); sum += c; cnt += (c > 0u) ? 1u : 0u; mine = (j == x) ? c : mine; }
        if (sum == G) break;
        __builtin_amdgcn_s_sleep(1);
        if ((++sp & 255u) == 0u) { if (xb_ld(&bar[XB_TMO])) break; if (sp > XB_SPIN_CAP) { atomicAdd(&bar[XB_TMO], 1u); break; } }
    }
    nloc = mine > 0u ? mine : 1u; nx = cnt > 0u ? cnt : 1u;
}

__device__ __forceinline__ void xcd_barrier(const XcdBarrier& b) {
    asm volatile("s_waitcnt vmcnt(0)" ::: "memory");
    __syncthreads();
    if (threadIdx.x == 0) {
        unsigned* bar = b.bar;
        __builtin_amdgcn_s_waitcnt(0);
        unsigned nloc = b.st[0], nx = b.st[1];
        if (nloc == 0u) { xcd_barrier_complete(bar, b.x, nloc, nx); b.st[0] = nloc; b.st[1] = nx; }
        const unsigned old = xb_add(&bar[XB_XSUB(b.x)], 1u);
        const unsigned gen = old / nloc;
        if (old + 1u == (gen + 1u) * nloc) {
            __builtin_amdgcn_fence(__ATOMIC_RELEASE, "agent");
            asm volatile("s_waitcnt vmcnt(0)" ::: "memory");
            const unsigned og = xb_add(&bar[XB_TOP], 1u);
            const unsigned tg = og / nx;
            if (og + 1u == (tg + 1u) * nx) xb_add(&bar[XB_TOPGEN], 1u);
            else XB_SPIN(xb_ld(&bar[XB_TOPGEN]) == tg, bar);
            __builtin_amdgcn_fence(__ATOMIC_ACQUIRE, "agent");
            xb_add(&bar[XB_XGEN(b.x)], 1u);
            asm volatile("s_waitcnt vmcnt(0)" ::: "memory");
        } else {
            XB_SPIN(xb_ld(&bar[XB_XGEN(b.x)]) == gen, bar);
            __builtin_amdgcn_fence(__ATOMIC_ACQUIRE, "agent");
            asm volatile("s_waitcnt vmcnt(0)" ::: "memory");
        }
    }
    __syncthreads();
}

#define GRID_SYNC() xcd_barrier(xbar)
__global__ void __launch_bounds__(NTHREADS, 2) mega_fwd(Params p) {
    extern __shared__ __attribute__((aligned(16))) unsigned char lds_raw[];
    LAS unsigned char* lds = (LAS unsigned char*)lds_raw;
    cg::grid_group grid = cg::this_grid();
    const int G = gridDim.x;
#ifdef DBG_DELAY_US
#pragma unroll 1
    for (int dly = 0; dly < DBG_DELAY_US / 3; ++dly) __builtin_amdgcn_s_sleep(127);
#endif
    volatile LAS unsigned* xst = (volatile LAS unsigned*)(lds + LDS_BYTES - 16);
    if (threadIdx.x < 2) xst[threadIdx.x] = 0u;
    __syncthreads();
    const XcdBarrier xbar = xcd_barrier_post((unsigned*)(p.ws + WS_CTL), xst);
    if (p.s_lo == 0) {
        {   int tid = threadIdx.x; asm volatile("" : "+v"(tid)); const int lane = tid & 63, wave = __builtin_amdgcn_readfirstlane(tid >> 6);
            prologue_phase(p, lds, tid, wave, lane);
            if (blockIdx.x < NB) {
                __syncthreads(); float* T0 = (float*)(p.ws + WS_T0); const int b = blockIdx.x;
                LAS float* h = (LAS float*)lds; LAS float* u = h + 1024; LAS float* red = h + 8192;
                t0_load(h, p.x + (size_t)b * T * D, 1024, tid); t0_rmsnorm_<false>(h, p.norm_g, u, red, tid);
                t0_store(T0 + T0_H + b * 1024, h, 1024, tid); t0_store(T0 + T0_U + b * 1024, u, 1024, tid); } }
        if (p.s_hi > 1) {
            asm volatile("s_waitcnt vmcnt(0) lgkmcnt(0)" ::: "memory"); __syncthreads();
            grid.sync();
            GRID_SYNC();
        }
    }

#pragma unroll 1
    for (int layer_i = 0; layer_i < DEPTH; ++layer_i) {
#pragma unroll 1
        for (int ph = 0; ph < 9; ++ph) {
            const int step = 1 + layer_i * 9 + ph; if (step < p.s_lo || step >= p.s_hi) continue;
            int layer = layer_i; asm volatile("" : "+s"(layer));
            const int li = layer >> 1; const bool odd = layer & 1;
            int tid = threadIdx.x; asm volatile("" : "+v"(tid)); const int lane = tid & 63, wave = __builtin_amdgcn_readfirstlane(tid >> 6);
            const int gw = blockIdx.x * NWAVES + wave, NGW = G * NWAVES;
            int wv = tid >> 6; asm volatile("" : "+v"(wv));
            const int bx = blockIdx.x & 7, rk = blockIdx.x >> 3, NL = G >> 3;
            unsigned char* ws = p.ws; asm volatile("" : "+s"(ws));
            bf16_t* U = (bf16_t*)(ws + WS_U); bf16_t* MIX = (bf16_t*)(ws + WS_MIX); bf16_t* Zb = (bf16_t*)(ws + WS_Z);
            {
                float* T0 = (float*)(ws + WS_T0); const float* ngl = p.norm_g + (size_t)layer * 4 * D; const int b = blockIdx.x;
                LAS float* h = (LAS float*)lds; LAS float* u = h + 1024; LAS float* z = u + 1024; LAS float* mix = z + 4096; LAS float* y = mix + 1024; LAS float* red = y + 1024; LAS float* sc = red + 16;
                if (ph == 0) t0_skinny(odd ? p.od_w_in + (size_t)li * 1024 * OD_IN : p.ev_w_in + (size_t)li * 1024 * EV_IN, 1024, odd ? OD_IN : EV_IN, T0 + T0_U, 1024, T0 + T0_Z, 4096, 0, lds, tid);
                else if (ph == 4) t0_skinny((odd ? p.od_w_out : p.ev_w_out) + (size_t)li * 1024 * 1024, 1024, 1024, T0 + T0_MIX, 1024, T0 + T0_Y, 1024, 0, lds, tid);
                else if (ph == 6) t0_skinny(p.w_up + (size_t)layer * 1024 * FF, 1024, FF, T0 + T0_U, 1024, T0 + T0_Z, 4096, 2, lds, tid);
                else if (ph == 7) t0_skinny(p.w_down + (size_t)layer * FF * 1024, FF, 1024, T0 + T0_Z, 4096, T0 + T0_Y, 1024, 0, lds, tid);
                else if (b < NB && ph == 1) { t0_load(z, T0 + T0_Z + b * 4096, 4096, tid); if (odd) t0_mix_odd(p, li, z, mix, sc, tid); else t0_mix_even(p, li, z, mix, sc, tid);
                    t0_store(T0 + T0_MIX + b * 1024, mix, 1024, tid); }
                else { }
            }
            if (ph == 0 || ph == 4 || ph == 6 || ph == 7) {
                pg8::Gemm g; pg8::EpiSt E; E.Of0 = nullptr; E.Of1 = nullptr;
                if (ph == 0) { g.A = layer == 0 ? U : (const bf16_t*)(ws + WS_ST); g.K = 1024; E.O = Zb; E.act = 0;
                    if (!odd) { g.Bt = (const bf16_t*)(ws + WS_EVIN) + (size_t)li * EV_IN * 1024; g.N = EV_IN; E.ldc = EV_IN; E.nvalid = EV_IN; }
                    else { g.Bt = (const bf16_t*)(ws + WS_ODIN) + (size_t)li * OD_INP * 1024; g.N = OD_INP; E.ldc = OD_LD; E.nvalid = OD_IN; } }
                else if (ph == 4) { g.A = MIX; g.K = 1024; g.N = 1024; g.Bt = (const bf16_t*)(ws + (odd ? WS_ODOUT : WS_EVOUT)) + (size_t)li * 1024 * 1024; E.O = U; E.ldc = 1024; E.nvalid = 1024; E.act = 0; E.Of0 = (float*)Zb; }
                else if (ph == 6) { g.A = U; g.K = 1024; g.N = FF; g.Bt = (const bf16_t*)(ws + WS_UP) + (size_t)layer * FF * 1024; E.O = Zb; E.ldc = FF; E.nvalid = FF; E.act = 2; }
                else { g.A = Zb; g.K = FF; g.N = 1024; g.Bt = (const bf16_t*)(ws + WS_DN) + (size_t)layer * 1024 * FF; E.O = U; E.ldc = 1024; E.nvalid = 1024; E.act = 0; E.Of0 = (float*)MIX; }
                g.M = M;
                XcdOrder S; S.init(g.N, G, (int)blockIdx.x);
                pg8::gemm_phase<pg8::EpiSt, XcdOrder, PG8_ALIGN_OPT, PG8_SP2_OPT>(lds, g, S, E);
#ifdef PROBE_DOUBLE_GEMM
                __syncthreads(); pg8::gemm_phase<pg8::EpiSt, XcdOrder, PG8_ALIGN_OPT, PG8_SP2_OPT>(lds, g, S, E);
#endif
            }
#ifndef NO_MIX
            else if (ph == 1) {
#ifdef PROBE_DOUBLE_MIX
              for (int rep = 0; rep < 2; ++rep)
#endif
              {
                if (!odd) { for (int ul = rk; ul < 128 + 64; ul += NL) { if (ul < 128) la1_unit<false>(lds, p, li, bx * 128 + ul, 0, tid, wv, lane);
                                else { const int s = ul - 128; swa_unit(lds, Zb, MIX, p.ev_sinks + li * 8, bx, (s >> 5) & 1, s & 31, tid, wv, lane); } } }
                else { for (int ul = rk; ul < 128; ul += NL) la1_unit<true>(lds, p, li, bx * 128 + ul, 0, tid, wv, lane); }
              }
            } else if (ph == 2) {
                if (!odd) la2_phase<false>(p, tid, bx, rk, NL); else la2_phase<true>(p, tid, bx, rk, NL);
            } else if (ph == 3) {
#ifdef PROBE_DOUBLE_MIX
              for (int rep = 0; rep < 2; ++rep)
#endif
              {
                if (!odd) { for (int ul = rk; ul < 128; ul += NL) la3_unit<false>(lds, p, li, bx * 128 + ul, tid, wv, lane); }
                else { for (int ul = rk; ul < 128; ul += NL) la3_unit<true>(lds, p, li, bx * 128 + ul, tid, wv, lane); }
              }
            }
#endif
            else if (ph == 5) {
                norm_phase((const float*)Zb, nullptr, layer == 0 ? p.x : p.out, p.out, p.norm_g + (layer * 4 + 1) * D, p.norm_g + (layer * 4 + 2) * D, U, gw, NGW, lane, (float*)(ws + WS_T0), false);
            } else {
                norm_phase((const float*)MIX, nullptr, p.out, p.out, p.norm_g + (layer * 4 + 3) * D, layer + 1 < DEPTH ? p.norm_g + ((layer + 1) * 4) * D : nullptr, (bf16_t*)(ws + WS_ST), gw, NGW, lane, (float*)(ws + WS_T0), layer + 1 == DEPTH);
            }
            if (step + 1 < p.s_hi) GRID_SYNC();
#ifdef PROBE_DOUBLE_BAR
            if (step + 1 < p.s_hi) GRID_SYNC();
#endif
        }
    }
    if (p.s_hi > 1 + 9 * DEPTH) {
        if (blockIdx.x < NB) { const float* T0 = (const float*)(p.ws + WS_T0); for (int i = threadIdx.x; i < D; i += NTHREADS) p.out[(size_t)blockIdx.x * T * D + i] = T0[T0_H + blockIdx.x * 1024 + i]; }
    }
}

#ifdef DBG_SEPK
__global__ void __launch_bounds__(NTHREADS, 2) k_mix1_even(Params p, int li) {
    extern __shared__ __attribute__((aligned(16))) unsigned char lds_raw2[];
    LAS unsigned char* lds = (LAS unsigned char*)lds_raw2;
    const int tid = threadIdx.x, lane = tid & 63, wave = __builtin_amdgcn_readfirstlane(tid >> 6);
    const int bx = blockIdx.x & 7, rk = blockIdx.x >> 3, NL = gridDim.x >> 3;
    bf16_t* MIX = (bf16_t*)(p.ws + WS_MIX); bf16_t* Zb = (bf16_t*)(p.ws + WS_Z);
    for (int ul = rk; ul < 128 + 64; ul += NL) { if (ul < 128) la1_unit<false>(lds, p, li, bx * 128 + ul, 0, tid, wv, lane);
        else { const int s = ul - 128; swa_unit(lds, Zb, MIX, p.ev_sinks + li * 8, bx, (s >> 5) & 1, s & 31, tid, wv, lane); } }
}
#endif
#ifdef DBG_T0CHK
__global__ void __launch_bounds__(NTHREADS, 2) k_t0chk(Params p) {
    extern __shared__ __attribute__((aligned(16))) unsigned char lds_raw3[];
    LAS unsigned char* lds = (LAS unsigned char*)lds_raw3; const int tid = threadIdx.x, b = blockIdx.x;
    LAS float* h = (LAS float*)lds; LAS float* u = h + 1024; LAS float* z = u + 1024; LAS float* red = z + 4096 + 2048;
    h[tid] = p.x[(size_t)b * T * D + tid]; h[tid + 512] = p.x[(size_t)b * T * D + tid + 512]; __syncthreads();
    t0_rmsnorm_<false>(h, p.norm_g, u, red, tid);
    t0_gemv(p.ev_w_in, 1024, EV_IN, u, z, 0, tid);
    const bf16_t* Zr = (const bf16_t*)(p.ws + WS_Z) + (size_t)b * T * EV_IN; const bf16_t* Ur = (const bf16_t*)(p.ws + WS_U) + (size_t)b * T * D;
    bool bad = false;
    for (int n = tid; n < EV_IN; n += NTHREADS) { const float zm = __uint_as_float((unsigned)Zr[n] << 16); if (fabsf(zm - z[n]) > 0.05f + 0.02f * fabsf(zm)) bad = true; }
    if (DBG_T0CHK == 3) { bad = false; for (int n = tid; n < D; n += NTHREADS) { const float um = __uint_as_float((unsigned)Ur[n] << 16); if (fabsf(um - u[n]) > 0.02f + 0.01f * fabsf(um)) bad = true; } }
    if (DBG_T0CHK >= 10) { t0_path(p, lds, b, tid, DBG_T0CHK - 10); return; }
    if (DBG_T0CHK == 2) { LAS float* mix = z + 4096; LAS float* sc = red + 16; t0_mix_even(p, 0, z, mix, sc, tid);
        const bf16_t* Mr = (const bf16_t*)(p.ws + WS_MIX) + (size_t)b * T * D; bad = false;
        for (int n = tid; n < D; n += NTHREADS) { const float mm = __uint_as_float((unsigned)Mr[n] << 16); if (fabsf(mm - mix[n]) > 0.05f + 0.05f * fabsf(mm)) bad = true; } }
    if (DBG_T0CHK == 5) { LAS float* mix = z + 4096; LAS float* sc = red + 16; LAS float* y = mix + 1024; t0_mix_even(p, 0, z, mix, sc, tid);
        t0_gemv(p.ev_w_out, 1024, 1024, mix, y, 0, tid); bad = false;
        for (int n = tid; n < D; n += NTHREADS) { const float um = __uint_as_float((unsigned)Ur[n] << 16); if (fabsf(um - y[n]) > 0.03f + 0.05f * fabsf(um)) bad = true; } }
    if (DBG_T0CHK == 6) { LAS float* mix = z + 4096; LAS float* sc = red + 16; LAS float* y = mix + 1024; t0_mix_even(p, 0, z, mix, sc, tid);
        t0_gemv(p.ev_w_out, 1024, 1024, mix, y, 0, tid); t0_rmsnorm_<true>(y, p.norm_g + D, h, red, tid); t0_rmsnorm_<false>(h, p.norm_g + 2 * D, u, red, tid); bad = false;
        for (int n = tid; n < D; n += NTHREADS) { const float hm = p.out[(size_t)b * T * D + n]; if (fabsf(hm - h[n]) > 0.03f + 0.03f * fabsf(hm)) bad = true;
            const float um = __uint_as_float((unsigned)Ur[n] << 16); if (fabsf(um - u[n]) > 0.03f + 0.03f * fabsf(um)) bad = true; } }
    __syncthreads();
    if (bad) p.out[(size_t)(b * T + T - 1) * D + tid] = __builtin_nanf("");
}
#endif
#ifdef DBG_STEPS
__global__ void dbg_dump(Params p) {
    const bf16_t* src = (const bf16_t*)(p.ws + (size_t)DBG_OFF_MIB * MiB);
    for (size_t idx = (size_t)blockIdx.x * blockDim.x + threadIdx.x; idx < (size_t)M * D; idx += (size_t)gridDim.x * blockDim.x) { const size_t m = idx >> 10, c = idx & 1023;
#ifndef DBG_W
#define DBG_W 1024
#endif
        p.out[idx] = c < DBG_W ? __uint_as_float((unsigned)src[m * DBG_LD + DBG_COL + c] << 16) : 0.f; }
}
#endif
extern "C" void kernel_launch(void* const* d_in, const int* in_sizes, int n_in, void* d_out, int out_size, void* d_ws, size_t ws_size, hipStream_t stream) {
    static int grid = 0;
    if (grid == 0) {
        if (n_in != 13 || in_sizes[0] != M * D || out_size != M * D || ws_size < WS_END) { fprintf(stderr, "kernel_launch: unexpected shapes / workspace (n_in %d, ws %zu)\n", n_in, ws_size); grid = -1; return; }
        int dev = 0, cus = 0, per_cu = 0;
        hipGetDevice(&dev); hipDeviceGetAttribute(&cus, hipDeviceAttributeMultiprocessorCount, dev);
        if (hipFuncSetAttribute((const void*)mega_fwd, hipFuncAttributeMaxDynamicSharedMemorySize, LDS_BYTES) != hipSuccess) { fprintf(stderr, "kernel_launch: hipFuncSetAttribute failed\n"); grid = -1; return; }
        if (hipOccupancyMaxActiveBlocksPerMultiprocessor(&per_cu, (const void*)mega_fwd, NTHREADS, LDS_BYTES) != hipSuccess || per_cu < 1) { fprintf(stderr, "kernel_launch: occupancy query gave %d\n", per_cu); per_cu = 1; }
        (void)hipGetLastError();
        grid = cus * per_cu;
    }
    if (grid < 0) return;
    Params p{};
    p.x = (const float*)d_in[0]; p.norm_g = (const float*)d_in[1]; p.w_up = (const float*)d_in[2]; p.w_down = (const float*)d_in[3]; p.ev_w_in = (const float*)d_in[4];
    p.ev_ret_norm_g = (const float*)d_in[5]; p.ev_sinks = (const float*)d_in[6]; p.ev_w_out = (const float*)d_in[7]; p.od_w_in = (const float*)d_in[8]; p.od_w_gate_up = (const float*)d_in[9];
    p.od_gate_bias = (const float*)d_in[10]; p.od_norm_g = (const float*)d_in[11]; p.od_w_out = (const float*)d_in[12];
    p.out = (float*)d_out; p.ws = (unsigned char*)d_ws;
    if (hipMemsetAsync((char*)d_ws + WS_CTL, 0, 16384, stream) != hipSuccess) { fprintf(stderr, "kernel_launch: memset failed\n"); return; }
#ifndef MK_PER_PHASE
#define MK_PER_PHASE 0
#endif
    constexpr int NSTEPS = 1 + 9 * DEPTH;
    if (MK_PER_PHASE) {
#ifdef DBG_STEPS
#ifndef DBG_SKIP_LO
#define DBG_SKIP_LO 0
#define DBG_SKIP_HI 0
#endif
#ifdef DBG_SEPK
        hipFuncSetAttribute((const void*)k_mix1_even, hipFuncAttributeMaxDynamicSharedMemorySize, LDS_BYTES);
#endif
        for (int st = 0; st < DBG_STEPS; ++st) { if (st >= DBG_SKIP_LO && st < DBG_SKIP_HI) continue; p.s_lo = st; p.s_hi = st + 1;
#ifdef DBG_SEPK
            if (st == 2) { hipLaunchKernelGGL(k_mix1_even, dim3(grid), dim3(NTHREADS), LDS_BYTES, stream, p, 0); continue; }
#endif
            hipLaunchKernelGGL(mega_fwd, dim3(grid), dim3(NTHREADS), LDS_BYTES, stream, p); }
#ifndef DBG_NODUMP
        hipLaunchKernelGGL(dbg_dump, dim3(2048), dim3(256), 0, stream, p);
#endif
#ifdef DBG_T0CHK
        hipLaunchKernelGGL(k_t0chk, dim3(8), dim3(NTHREADS), 65536, stream, p);
#endif
#else
        for (int st = 0; st < NSTEPS; ++st) { p.s_lo = st; p.s_hi = st + 1; hipLaunchKernelGGL(mega_fwd, dim3(grid), dim3(NTHREADS), LDS_BYTES, stream, p); }
#endif
    } else {
        p.s_lo = 0; p.s_hi = NSTEPS;
        void* args[] = {&p};
        hipError_t e = hipLaunchCooperativeKernel((const void*)mega_fwd, dim3(grid), dim3(NTHREADS), args, LDS_BYTES, stream);
        if (e != hipSuccess) fprintf(stderr, "kernel_launch: cooperative launch failed: %s (grid %d)\n", hipGetErrorString(e), grid);
    }
}
```

```cpp
#include <hip/hip_runtime.h>
#include <cstdio>
#include <cstdint>
#include <cmath>
namespace pg8 {
#define PG8_LAS __attribute__((address_space(3)))
typedef unsigned short bf16_t;
typedef short bf16x8 __attribute__((ext_vector_type(8)));
typedef float f32x4 __attribute__((ext_vector_type(4)));
typedef unsigned u32x4 __attribute__((ext_vector_type(4)));
constexpr int BM = 256, BK = 64, HALF = 128, HTB = HALF * BK * 2  , STAGE_BYTES = 8 * HTB, NXCD = 8, WGM = 8;

__host__ __device__ __forceinline__ int lds_byte(int r, int c) { const int st = (r >> 4) * 2 + (c >> 5), rr = r & 15, cc = c & 31, ob = rr * 64 + cc * 2; return st * 1024 + (ob ^ (((ob >> 9) & 1) << 5)); }
__host__ __device__ __forceinline__ void stage_rc(int b, int& R, int& C) { const int st = b / 1024, sb = b % 1024, swz = sb ^ (((sb >> 9) & 1) << 5); R = (st >> 1) * 16 + swz / 64; C = (st & 1) * 32 + (swz % 64) / 2; }
__host__ __device__ __forceinline__ int perm32(int rho) { const int n = rho >> 4, i = rho & 15; return 8 * (i >> 2) + 4 * n + (i & 3); }

struct Unit { int pm, pn; };
struct Gemm { const bf16_t* A; const bf16_t* Bt; int M, N, K; };

struct StaticOrder {
    int nM, nN, nwg, G, c;
    __host__ __device__ void init(int M, int N, int G_, int c_) { nM = M / BM; nN = N / BM; nwg = nM * nN; G = G_; c = c_; }
    __host__ __device__ bool next(int i, Unit& u) const {
        const long L = (long)i * G + c; if (L >= nwg) return false;
        int wgid = (int)L; { const int q = nwg / NXCD, r = nwg % NXCD, xcd = wgid % NXCD, off = wgid / NXCD; wgid = (xcd < r ? xcd * (q + 1) : r * (q + 1) + (xcd - r) * q) + off; }
        const int nig = WGM * nN, gid = wgid / nig, fm = gid * WGM, gsz = (nM - fm) < WGM ? (nM - fm) : WGM;
        u.pm = fm + ((wgid % nig) % gsz); u.pn = (wgid % nig) / gsz; return true;
    }
    __device__ __forceinline__ void a_ready(const Unit&) const {}
    __device__ __forceinline__ void done(const Unit&) const {}
};

typedef __bf16 bf16x2_t __attribute__((ext_vector_type(2)));
typedef float f32x2_t __attribute__((ext_vector_type(2)));
__device__ __forceinline__ unsigned cvt_pk_bf16(float lo, float hi) { const f32x2_t v = {lo, hi}; const bf16x2_t b = __builtin_convertvector(v, bf16x2_t); return __builtin_bit_cast(unsigned, b); }
struct EpiSt {
    static constexpr bool PERM = true, AFTER_DRAIN = false;
    bf16_t* O; int ldc; int nvalid; int act; float* Of0; float* Of1;
    __device__ __forceinline__ void operator()(const f32x4 (&acc)[2][2][4][2], const Unit& u, int wr, int wc, int fr, int fq) const {
        const int row0 = u.pm * BM + wr * 64 + fr; const int col0 = u.pn * BM + wc * 32 + 8 * fq;
        if (Of0) {
            typedef _Float16 h2_t __attribute__((ext_vector_type(2))); typedef float f2_t __attribute__((ext_vector_type(2)));
            unsigned short* Oh = (unsigned short*)Of0;
#pragma unroll
            for (int ai = 0; ai < 2; ++ai)
#pragma unroll
                for (int m = 0; m < 4; ++m) { unsigned short* rowp = Oh + (size_t)(row0 + ai * HALF + m * 16) * 1024 + col0;
#pragma unroll
                    for (int bj = 0; bj < 2; ++bj) { const f32x4 v0 = acc[ai][bj][m][0], v1 = acc[ai][bj][m][1]; u32x4 w;
                        w.x = __builtin_bit_cast(unsigned, __builtin_convertvector((f2_t){v0[0], v0[1]}, h2_t)); w.y = __builtin_bit_cast(unsigned, __builtin_convertvector((f2_t){v0[2], v0[3]}, h2_t));
                        w.z = __builtin_bit_cast(unsigned, __builtin_convertvector((f2_t){v1[0], v1[1]}, h2_t)); w.w = __builtin_bit_cast(unsigned, __builtin_convertvector((f2_t){v1[2], v1[3]}, h2_t));
                        *(u32x4*)(rowp + bj * HALF) = w; } }
            return;
        }
#pragma unroll
        for (int ai = 0; ai < 2; ++ai)
#pragma unroll
            for (int m = 0; m < 4; ++m) { bf16_t* rowp = O + (size_t)(row0 + ai * HALF + m * 16) * ldc + col0;
#pragma unroll
                for (int bj = 0; bj < 2; ++bj) { f32x4 v0 = acc[ai][bj][m][0], v1 = acc[ai][bj][m][1];
                    if (act == 2) {
#pragma unroll
                        for (int e = 0; e < 4; ++e) { const float a = fmaxf(v0[e], 0.f), b = fmaxf(v1[e], 0.f); v0[e] = a * a; v1[e] = b * b; } }
                    u32x4 w; w.x = cvt_pk_bf16(v0[0], v0[1]); w.y = cvt_pk_bf16(v0[2], v0[3]); w.z = cvt_pk_bf16(v1[0], v1[1]); w.w = cvt_pk_bf16(v1[2], v1[3]);
                    if (col0 + bj * HALF + 8 <= nvalid) *(u32x4*)(rowp + bj * HALF) = w; } }
    }
};

template <class Epi, class Sched, bool ALIGN_EPI = false, bool SP2 = false>
__device__ __forceinline__ void gemm_phase(PG8_LAS unsigned char* lds, const Gemm g, const Sched& S, const Epi& E) {
    int tid = threadIdx.x; asm volatile("" : "+v"(tid));
    const int wid = __builtin_amdgcn_readfirstlane(tid >> 6), lane = tid & 63, wr = wid >> 2, wc = wid & 3, fr = lane & 15, fq = lane >> 4;
    const int K = g.K, nt = K / BK;
    unsigned voffA[2], voffB[2];
#pragma unroll
    for (int i = 0; i < 2; ++i) { int R, C; stage_rc(tid * 16 + i * 8192, R, C); const int Rb = Epi::PERM ? ((R & ~31) + perm32(R & 31)) : R;
        voffA[i] = (unsigned)(R * K + C) * 2u; voffB[i] = (unsigned)(Rb * K + C) * 2u; }
    const size_t kstep = (size_t)(BK * 2);
    const size_t hstep = (size_t)HALF * K * 2;
    const size_t tstep = 2 * hstep;
    const unsigned ldsw = (unsigned)wid * 1024u;
    const int aoff = lds_byte(wr * 64 + fr, fq * 8), boff = lds_byte(wc * 32 + fr, fq * 8);
#define PG8_SA(b, h) (((b) * 2 + (h)) * HTB)
#define PG8_SB(b, h) ((4 + (b) * 2 + (h)) * HTB)
#define PG8_STAGE(bufoff, gbase, voff) do { _Pragma("unroll") for (int _i = 0; _i < 2; ++_i) \
        __builtin_amdgcn_global_load_lds((const unsigned*)((const char*)(gbase) + (voff)[_i]), (PG8_LAS unsigned*)(lds + (bufoff) + ldsw + _i * 8192), 16, 0, 0); } while (0)
#define PG8_LDA(dst, b, h) do { _Pragma("unroll") for (int m = 0; m < 4; ++m) _Pragma("unroll") for (int k = 0; k < 2; ++k) dst[m][k] = *(const PG8_LAS bf16x8*)(lds + PG8_SA(b, h) + aoff + m * 2048 + k * 1024); } while (0)
#define PG8_LDB(dst, b, h) do { _Pragma("unroll") for (int n = 0; n < 2; ++n) _Pragma("unroll") for (int k = 0; k < 2; ++k) dst[n][k] = *(const PG8_LAS bf16x8*)(lds + PG8_SB(b, h) + boff + n * 2048 + k * 1024); } while (0)
#define PG8_MMA(ai, bj, At, Bt) do { __builtin_amdgcn_s_setprio(1); _Pragma("unroll") for (int m = 0; m < 4; ++m) _Pragma("unroll") for (int n = 0; n < 2; ++n) _Pragma("unroll") for (int k = 0; k < 2; ++k) \
        acc[ai][bj][m][n] = __builtin_amdgcn_mfma_f32_16x16x32_bf16(Bt[n][k], At[m][k], acc[ai][bj][m][n], 0, 0, 0); __builtin_amdgcn_s_setprio(0); } while (0)
#define PG8_WAIT_V(n) asm volatile("s_waitcnt vmcnt(" #n ")" ::: "memory")
#define PG8_WAIT_L(n) asm volatile("s_waitcnt lgkmcnt(" #n ")" ::: "memory")
#define PG8_BAR __builtin_amdgcn_s_barrier()
#define PG8_SCHED __builtin_amdgcn_sched_barrier(0)
    Unit cur, nxt; int ui = 0;
    if (!S.next(0, cur)) return;
    f32x4 acc[2][2][4][2];
#pragma unroll
    for (int a = 0; a < 2; ++a)
#pragma unroll
        for (int b = 0; b < 2; ++b)
#pragma unroll
            for (int m = 0; m < 4; ++m)
#pragma unroll
                for (int n = 0; n < 2; ++n) acc[a][b][m][n] = (f32x4){0.f, 0.f, 0.f, 0.f};
    bf16x8 At[4][2], B0[2][2], B1[2][2];
    const char* cA = (const char*)g.A + (size_t)cur.pm * tstep; const char* cB = (const char*)g.Bt + (size_t)cur.pn * tstep;
    S.a_ready(cur);
    if constexpr (SP2) {
        PG8_STAGE(PG8_SB(0, 0), cB, voffB); PG8_STAGE(PG8_SB(0, 1), cB + hstep, voffB); PG8_STAGE(PG8_SA(0, 0), cA, voffA); PG8_STAGE(PG8_SA(0, 1), cA + hstep, voffA);
        if (wr == 1) PG8_BAR;
        PG8_WAIT_V(2); PG8_BAR;
        PG8_STAGE(PG8_SB(1, 0), cB + kstep, voffB); PG8_STAGE(PG8_SA(1, 0), cA + kstep, voffA); PG8_STAGE(PG8_SB(1, 1), cB + hstep + kstep, voffB);
        PG8_WAIT_V(6); PG8_BAR;
    } else {
        PG8_STAGE(PG8_SB(0, 0), cB, voffB); PG8_STAGE(PG8_SA(0, 0), cA, voffA); PG8_STAGE(PG8_SB(0, 1), cB + hstep, voffB); PG8_STAGE(PG8_SA(0, 1), cA + hstep, voffA);
        if (wr == 1) PG8_BAR;
        PG8_WAIT_V(4); PG8_BAR;
        PG8_STAGE(PG8_SB(1, 0), cB + kstep, voffB); PG8_STAGE(PG8_SA(1, 0), cA + kstep, voffA); PG8_STAGE(PG8_SB(1, 1), cB + hstep + kstep, voffB);
        PG8_WAIT_V(6); PG8_BAR;
    }
    for (;;) {
        const bool has_next = S.next(ui + 1, nxt);
        const char* nA = has_next ? (const char*)g.A + (size_t)nxt.pm * tstep : cA; const char* nB = has_next ? (const char*)g.Bt + (size_t)nxt.pn * tstep : cB;
        for (int t = 0; t < nt; t += 2) {
            const bool last = (t == nt - 2);
            const char* a1 = cA + (size_t)(t + 1) * kstep;
            const char* a2 = last ? nA : cA + (size_t)(t + 2) * kstep; const char* b2 = last ? nB : cB + (size_t)(t + 2) * kstep;
            const char* a3 = a2 + kstep; const char* b3 = b2 + kstep;
            if (last && has_next) S.a_ready(nxt);
            if constexpr (SP2) {
            PG8_LDB(B0, 0, 0); PG8_LDB(B1, 0, 1); PG8_SCHED; PG8_LDA(At, 0, 0); PG8_STAGE(PG8_SA(1, 1), a1 + hstep, voffA);
            PG8_WAIT_V(8); PG8_WAIT_L(0); PG8_BAR; PG8_MMA(0, 0, At, B0); PG8_MMA(0, 1, At, B1); PG8_BAR; PG8_SCHED;
            PG8_LDA(At, 0, 1); PG8_STAGE(PG8_SB(0, 0), b2, voffB); PG8_STAGE(PG8_SB(0, 1), b2 + hstep, voffB); PG8_STAGE(PG8_SA(0, 0), a2, voffA);
            PG8_WAIT_V(8); PG8_WAIT_L(0); PG8_BAR; PG8_MMA(1, 0, At, B0); PG8_MMA(1, 1, At, B1); PG8_BAR; PG8_SCHED;
            PG8_LDB(B0, 1, 0); PG8_LDB(B1, 1, 1); PG8_SCHED; PG8_LDA(At, 1, 0); PG8_STAGE(PG8_SA(0, 1), a2 + hstep, voffA);
            PG8_WAIT_V(8); PG8_WAIT_L(0); PG8_BAR; PG8_MMA(0, 0, At, B0); PG8_MMA(0, 1, At, B1); PG8_BAR; PG8_SCHED;
            PG8_LDA(At, 1, 1); PG8_STAGE(PG8_SB(1, 0), b3, voffB); PG8_STAGE(PG8_SB(1, 1), b3 + hstep, voffB); PG8_STAGE(PG8_SA(1, 0), a3, voffA);
            PG8_WAIT_V(8); PG8_WAIT_L(0); PG8_BAR; PG8_MMA(1, 0, At, B0); PG8_MMA(1, 1, At, B1); PG8_BAR; PG8_SCHED;
            } else {
            PG8_LDB(B0, 0, 0); PG8_SCHED; PG8_LDA(At, 0, 0); PG8_STAGE(PG8_SA(1, 1), a1 + hstep, voffA);
            PG8_WAIT_L(8); PG8_BAR; PG8_WAIT_L(0); PG8_MMA(0, 0, At, B0); PG8_BAR; PG8_SCHED;
            PG8_LDB(B1, 0, 1); PG8_STAGE(PG8_SB(0, 0), b2, voffB);
            PG8_BAR; PG8_WAIT_L(0); PG8_MMA(0, 1, At, B1); PG8_BAR;
            PG8_LDA(At, 0, 1); PG8_STAGE(PG8_SA(0, 0), a2, voffA);
            PG8_BAR; PG8_WAIT_L(0); PG8_MMA(1, 0, At, B0); PG8_BAR; PG8_SCHED;
            PG8_STAGE(PG8_SB(0, 1), b2 + hstep, voffB);
            PG8_WAIT_V(6); PG8_BAR; PG8_MMA(1, 1, At, B1); PG8_BAR;
            PG8_LDB(B0, 1, 0); PG8_SCHED; PG8_LDA(At, 1, 0); PG8_STAGE(PG8_SA(0, 1), a2 + hstep, voffA);
            PG8_WAIT_L(8); PG8_BAR; PG8_WAIT_L(0); PG8_MMA(0, 0, At, B0); PG8_BAR; PG8_SCHED;
            PG8_LDB(B1, 1, 1); PG8_STAGE(PG8_SB(1, 0), b3, voffB);
            PG8_BAR; PG8_WAIT_L(0); PG8_MMA(0, 1, At, B1); PG8_BAR;
            PG8_LDA(At, 1, 1); PG8_STAGE(PG8_SA(1, 0), a3, voffA);
            PG8_BAR; PG8_WAIT_L(0); PG8_MMA(1, 0, At, B0); PG8_BAR; PG8_SCHED;
            PG8_STAGE(PG8_SB(1, 1), b3 + hstep, voffB);
            PG8_WAIT_V(6); PG8_BAR; PG8_MMA(1, 1, At, B1); PG8_BAR;
            }
        }
        if constexpr (ALIGN_EPI) { if (wr == 0) PG8_BAR; }
        if constexpr (!Epi::AFTER_DRAIN) { E(acc, cur, wr, wc, fr, fq); S.done(cur); }
        if (!has_next) break;
#pragma unroll
        for (int a = 0; a < 2; ++a)
#pragma unroll
            for (int b = 0; b < 2; ++b)
#pragma unroll
                for (int m = 0; m < 4; ++m)
#pragma unroll
                    for (int n = 0; n < 2; ++n) acc[a][b][m][n] = (f32x4){0.f, 0.f, 0.f, 0.f};
        cur = nxt; cA = nA; cB = nB; ++ui;
        if constexpr (ALIGN_EPI) { if (wr == 1) PG8_BAR; }
    }
    PG8_WAIT_V(0);
    if constexpr (!ALIGN_EPI) { if (wr == 0) PG8_BAR; }
    PG8_BAR;
    if constexpr (Epi::AFTER_DRAIN) { E.fused(acc, cur, wr, wc, fr, fq, lds, wid, lane); S.done(cur); }
#undef PG8_SA
#undef PG8_SB
#undef PG8_STAGE
#undef PG8_LDA
#undef PG8_LDB
#undef PG8_MMA
#undef PG8_WAIT_V
#undef PG8_WAIT_L
#undef PG8_BAR
#undef PG8_SCHED
}
}
#include <hip/hip_cooperative_groups.h>
namespace cg = cooperative_groups;
#define LAS __attribute__((address_space(3)))
typedef unsigned short bf16_t;
typedef short bf16x8 __attribute__((ext_vector_type(8)));
typedef float f32x4 __attribute__((ext_vector_type(4)));
typedef unsigned u32x4 __attribute__((ext_vector_type(4)));
typedef unsigned u32x2 __attribute__((ext_vector_type(2)));

constexpr int NB = 8, T = 4096, D = 1024, M = NB * T, FF = 4096, DEPTH = 4;
constexpr int EV_IN = 2816, OD_IN = 3088, OD_INP = 3328, OD_LD = 3328;
constexpr float EPS = 1e-6f;
constexpr int NTHREADS = 512, NWAVES = 8;
constexpr int LDS_BYTES = 147456;

constexpr size_t MiB = 1u << 20;
constexpr size_t WS_EVIN = 0;
constexpr size_t WS_ODIN = 11 * MiB;
constexpr size_t WS_UP = 24 * MiB;
constexpr size_t WS_DN = 56 * MiB;
constexpr size_t WS_EVOUT = 88 * MiB;
constexpr size_t WS_ODOUT = 92 * MiB;
constexpr size_t WS_ROT = 96 * MiB;
constexpr size_t WS_U = 98 * MiB;
constexpr size_t WS_MIX = 162 * MiB;
constexpr size_t WS_Z = 226 * MiB;
constexpr size_t WS_ST = 434 * MiB;
constexpr size_t WS_DEC = 498 * MiB;
constexpr size_t WS_CTL = 499 * MiB;
constexpr size_t WS_END = 500 * MiB;

struct Params {
    const float* x; const float* norm_g; const float* w_up; const float* w_down; const float* ev_w_in; const float* ev_ret_norm_g; const float* ev_sinks;
    const float* ev_w_out; const float* od_w_in; const float* od_w_gate_up; const float* od_gate_bias; const float* od_norm_g; const float* od_w_out;
    float* out; unsigned char* ws;
    int s_lo, s_hi;
};

__device__ __forceinline__ float wave_sum(float v) {
#pragma unroll
    for (int o = 1; o < 64; o <<= 1) v += __shfl_xor(v, o);
    return v;
}
__device__ __forceinline__ float lo_bf(unsigned w) { return __uint_as_float(w << 16); }
__device__ __forceinline__ float hi_bf(unsigned w) { return __uint_as_float(w & 0xffff0000u); }
__device__ __forceinline__ unsigned pk2(float lo, float hi) { return pg8::cvt_pk_bf16(lo, hi); }
__device__ __forceinline__ unsigned short f2bf(float f) { return (unsigned short)(pg8::cvt_pk_bf16(f, 0.f) & 0xffffu); }
__device__ __forceinline__ void unpack8(const u32x4 v, float (&f)[8]) {
    f[0] = lo_bf(v.x); f[1] = hi_bf(v.x); f[2] = lo_bf(v.y); f[3] = hi_bf(v.y); f[4] = lo_bf(v.z); f[5] = hi_bf(v.z); f[6] = lo_bf(v.w); f[7] = hi_bf(v.w);
}
__device__ __forceinline__ u32x4 pack8(const float (&f)[8]) { u32x4 w; w.x = pk2(f[0], f[1]); w.y = pk2(f[2], f[3]); w.z = pk2(f[4], f[5]); w.w = pk2(f[6], f[7]); return w; }
#define LDS_WAIT() asm volatile("s_waitcnt lgkmcnt(0)" ::: "memory")
#define MFMA16(b, a, c) __builtin_amdgcn_mfma_f32_16x16x32_bf16((b), (a), (c), 0, 0, 0)

__device__ __forceinline__ void transpose_item(const float* W, int K, int N, bf16_t* WT, LAS float* scr, int item, int nblk, int lane) {
    const int kb = item / nblk, nb = item % nblk, k0 = 64 * kb, n0 = 32 * nb;
    const int nn = n0 + (lane & 31); const bool ok = nn < N;
    float v[32];
    const float* wp = W + (size_t)(k0 + (lane >> 5)) * N + (ok ? nn : 0);
#pragma unroll
    for (int i = 0; i < 32; ++i) v[i] = wp[(size_t)(2 * i) * N];
#pragma unroll
    for (int i = 0; i < 32; ++i) { const int kk = 2 * i + (lane >> 5); scr[kk * 33 + (lane & 31)] = ok ? v[i] : 0.f; }
    LDS_WAIT();
    const int c = lane & 7;
#pragma unroll
    for (int j = 0; j < 4; ++j) { const int n = (lane >> 3) + 8 * j; const LAS float* s = scr + (8 * c) * 33 + n;
        u32x4 o; o.x = pk2(s[0 * 33], s[1 * 33]); o.y = pk2(s[2 * 33], s[3 * 33]); o.z = pk2(s[4 * 33], s[5 * 33]); o.w = pk2(s[6 * 33], s[7 * 33]);
        *(u32x4*)(WT + (size_t)(n0 + n) * K + k0 + 8 * c) = o; }
    LDS_WAIT();
}
__device__ __forceinline__ void mat_desc(const Params& p, int mi, const float*& W, int& K, int& N, int& NP, bf16_t*& WT) {
    unsigned char* ws = p.ws;
    if (mi < 2) { W = p.ev_w_in + (size_t)mi * 1024 * EV_IN; K = 1024; N = EV_IN; NP = EV_IN; WT = (bf16_t*)(ws + WS_EVIN) + (size_t)mi * EV_IN * 1024; }
    else if (mi < 4) { const int i = mi - 2; W = p.od_w_in + (size_t)i * 1024 * OD_IN; K = 1024; N = OD_IN; NP = OD_INP; WT = (bf16_t*)(ws + WS_ODIN) + (size_t)i * OD_INP * 1024; }
    else if (mi < 8) { const int l = mi - 4; W = p.w_up + (size_t)l * 1024 * FF; K = 1024; N = FF; NP = FF; WT = (bf16_t*)(ws + WS_UP) + (size_t)l * FF * 1024; }
    else if (mi < 12) { const int l = mi - 8; W = p.w_down + (size_t)l * FF * 1024; K = FF; N = 1024; NP = 1024; WT = (bf16_t*)(ws + WS_DN) + (size_t)l * 1024 * FF; }
    else if (mi < 14) { const int i = mi - 12; W = p.ev_w_out + (size_t)i * 1024 * 1024; K = 1024; N = 1024; NP = 1024; WT = (bf16_t*)(ws + WS_EVOUT) + (size_t)i * 1024 * 1024; }
    else { const int i = mi - 14; W = p.od_w_out + (size_t)i * 1024 * 1024; K = 1024; N = 1024; NP = 1024; WT = (bf16_t*)(ws + WS_ODOUT) + (size_t)i * 1024 * 1024; }
}

__device__ __forceinline__ void norm_phase(const float* Y, const float* Y1, const float* hin, float* hout, const float* g_post, const float* g_pre, bf16_t* U, int gw, int NGW, int lane, float* t0 = nullptr, bool t0_final = false) {
    const int bx = gw / NWAVES % 8, lw = (gw / NWAVES / 8) * NWAVES + gw % NWAVES, NLW = NGW / 8;
    constexpr int NR = 4;
    for (int ml = lw; ml < T; ml += NR * NLW) {
        int m[NR];
#pragma unroll
        for (int q = 0; q < NR; ++q) m[q] = bx * T + ml + q * NLW;
        f32x4 h[NR][4], y[NR][4];
#pragma unroll
        for (int q = 0; q < NR; ++q) { const f32x4* hr = (const f32x4*)(hin + (size_t)m[q] * D) + lane;
#pragma unroll
            for (int j = 0; j < 4; ++j) h[q][j] = __builtin_nontemporal_load(&hr[64 * j]);
            if (Y) { typedef _Float16 h4_t __attribute__((ext_vector_type(4))); const h4_t* yr = (const h4_t*)((const unsigned short*)Y + (size_t)m[q] * D) + lane;
#pragma unroll
                for (int j = 0; j < 4; ++j) { const h4_t yh = __builtin_nontemporal_load(&yr[64 * j]); y[q][j] = (f32x4){(float)yh[0], (float)yh[1], (float)yh[2], (float)yh[3]}; } } }
        if (Y) {
            float s[NR];
#pragma unroll
            for (int q = 0; q < NR; ++q) { s[q] = 0.f;
#pragma unroll
                for (int j = 0; j < 4; ++j) s[q] += (y[q][j][0] * y[q][j][0] + y[q][j][1] * y[q][j][1]) + (y[q][j][2] * y[q][j][2] + y[q][j][3] * y[q][j][3]); }

#pragma unroll
            for (int q = 0; q < NR; ++q) s[q] = wave_sum(s[q]);
            const f32x4* gp = (const f32x4*)g_post + lane;
#pragma unroll
            for (int q = 0; q < NR; ++q) { const float r = rsqrtf(s[q] * (1.f / D) + EPS); f32x4* ho = (f32x4*)(hout + (size_t)m[q] * D) + lane;
#pragma unroll
                for (int j = 0; j < 4; ++j) { h[q][j] = h[q][j] + y[q][j] * r * gp[64 * j]; __builtin_nontemporal_store(h[q][j], &ho[64 * j]); } }
        }
        if (g_pre) {
            float s[NR];
#pragma unroll
            for (int q = 0; q < NR; ++q) { s[q] = 0.f;
#pragma unroll
                for (int j = 0; j < 4; ++j) s[q] += (h[q][j][0] * h[q][j][0] + h[q][j][1] * h[q][j][1]) + (h[q][j][2] * h[q][j][2] + h[q][j][3] * h[q][j][3]); }

#pragma unroll
            for (int q = 0; q < NR; ++q) s[q] = wave_sum(s[q]);
            const f32x4* gp = (const f32x4*)g_pre + lane;
#pragma unroll
            for (int q = 0; q < NR; ++q) { const float r = rsqrtf(s[q] * (1.f / D) + EPS); u32x2* uo = (u32x2*)(U + (size_t)m[q] * D) + lane;
#pragma unroll
                for (int j = 0; j < 4; ++j) { const f32x4 v = h[q][j] * r * gp[64 * j]; u32x2 w; w.x = pk2(v[0], v[1]); w.y = pk2(v[2], v[3]); uo[64 * j] = w; } }
        }
    }
    if (t0 && lw == 0) {
        constexpr int T0_H_ = 0, T0_U_ = 8192, T0_Y_ = 57344;
        f32x4* hr = (f32x4*)(t0 + T0_H_ + bx * 1024) + lane; const f32x4* yr = (const f32x4*)(t0 + T0_Y_ + bx * 1024) + lane;
        f32x4 h[4], y[4]; float s = 0.f;
#pragma unroll
        for (int j = 0; j < 4; ++j) { h[j] = hr[64 * j]; y[j] = yr[64 * j]; s += (y[j][0] * y[j][0] + y[j][1] * y[j][1]) + (y[j][2] * y[j][2] + y[j][3] * y[j][3]); }
        const float r = rsqrtf(wave_sum(s) * (1.f / D) + EPS); const f32x4* gp = (const f32x4*)g_post + lane;
#pragma unroll
        for (int j = 0; j < 4; ++j) { h[j] = h[j] + y[j] * r * gp[64 * j]; hr[64 * j] = h[j]; }
        if (t0_final) { f32x4* ho = (f32x4*)(hout + (size_t)bx * T * D) + lane;
#pragma unroll
            for (int j = 0; j < 4; ++j) ho[64 * j] = h[j]; }
        if (g_pre) { float s2 = 0.f;
#pragma unroll
            for (int j = 0; j < 4; ++j) s2 += (h[j][0] * h[j][0] + h[j][1] * h[j][1]) + (h[j][2] * h[j][2] + h[j][3] * h[j][3]);
            const float r2 = rsqrtf(wave_sum(s2) * (1.f / D) + EPS); const f32x4* gq = (const f32x4*)g_pre + lane; f32x4* ur = (f32x4*)(t0 + T0_U_ + bx * 1024) + lane;
#pragma unroll
            for (int j = 0; j < 4; ++j) ur[64 * j] = h[j] * r2 * gq[64 * j]; }
    }
}
__device__ __forceinline__ void prologue_phase(const Params& p, LAS unsigned char* lds, int tid, int wave, int lane) {
    const int G = gridDim.x, gw = blockIdx.x * NWAVES + wave, NGW = G * NWAVES;
    LAS float* scr = (LAS float*)(lds + wave * 16384);
    constexpr int NITEMS = 2 * 16 * 88 + 2 * 16 * 104 + 4 * 16 * 128 + 4 * 64 * 32 + 4 * 16 * 32;
    for (int it = gw; it < NITEMS; it += NGW) {
        int r = it, mi = 0;
        for (; mi < 16; ++mi) { const int cnt = mi < 2 ? 16 * 88 : mi < 4 ? 16 * 104 : mi < 8 ? 16 * 128 : mi < 12 ? 64 * 32 : 16 * 32; if (r < cnt) break; r -= cnt; }
        const float* W; int K, N, NP; bf16_t* WT; mat_desc(p, mi, W, K, N, NP, WT);
        transpose_item(W, K, N, WT, scr, r, NP / 32, lane);
    }
    float* cosT = (float*)(p.ws + WS_ROT); float* sinT = cosT + T * 64;
    for (int idx = blockIdx.x * NTHREADS + tid; idx < T * 64; idx += G * NTHREADS) {
        const int pos = idx >> 6, i = idx & 63;
        const float invf = (float)exp(-(double)i * (9.210340371976184 / 64.0));
        const float angf = (float)pos * invf;
        double rv = (double)angf * 0.15915494309189535; rv -= floor(rv);
        const float rf = (float)rv;
        cosT[idx] = __builtin_amdgcn_cosf(rf); sinT[idx] = __builtin_amdgcn_sinf(rf);
    }
    norm_phase(nullptr, nullptr, p.x, nullptr, nullptr, p.norm_g, (bf16_t*)(p.ws + WS_U), gw, NGW, lane);
}

constexpr int SW_KS = 72, SW_VS = 280, SW_PS = 168;
constexpr int SW_K_OFF = 0, SW_V_OFF = 272 * SW_KS * 2, SW_P_OFF = SW_V_OFF + 64 * SW_VS * 2;
static_assert(SW_P_OFF + 8 * 16 * SW_PS * 2 <= LDS_BYTES, "swa lds");
__device__ __forceinline__ void swa_unit(LAS unsigned char* lds, const bf16_t* Z, bf16_t* MIX, const float* sinks, int b, int kvh, int n, int tid, int w, int lane) {
    LAS bf16_t* Ks = (LAS bf16_t*)(lds + SW_K_OFF); LAS bf16_t* VTs = (LAS bf16_t*)(lds + SW_V_OFF); LAS bf16_t* Pw = (LAS bf16_t*)(lds + SW_P_OFF) + w * 16 * SW_PS;
    const int fr = lane & 15, fq = lane >> 4;
    const size_t rowb = (size_t)b * T;
    {   u32x4 kv[5];
#pragma unroll
        for (int i = 0; i < 5; ++i) { const int idx = tid + i * NTHREADS, jj = idx >> 3, c = idx & 7; const int t = n * 128 - 128 + jj;
            kv[i] = (u32x4){0u, 0u, 0u, 0u};
            if (idx < 272 * 8 && jj < 256 && t >= 0) kv[i] = *(const u32x4*)(Z + (rowb + t) * EV_IN + 2560 + kvh * 64 + c * 8); }
#pragma unroll
        for (int i = 0; i < 5; ++i) { const int idx = tid + i * NTHREADS, jj = idx >> 3, c = idx & 7; if (idx < 272 * 8) *(LAS u32x4*)(Ks + jj * SW_KS + c * 8) = kv[i]; } }
    { const int jj = tid & 255, eh = tid >> 8; const int t = n * 128 - 128 + jj;
#pragma unroll
        for (int c = 0; c < 4; ++c) { u32x4 v = (u32x4){0u, 0u, 0u, 0u};
            if (t >= 0) v = *(const u32x4*)(Z + (rowb + t) * EV_IN + 2688 + kvh * 64 + eh * 32 + c * 8);
            LAS bf16_t* dst = VTs + (eh * 32 + c * 8) * SW_VS + jj;
            dst[0 * SW_VS] = (bf16_t)(v.x & 0xffffu); dst[1 * SW_VS] = (bf16_t)(v.x >> 16); dst[2 * SW_VS] = (bf16_t)(v.y & 0xffffu); dst[3 * SW_VS] = (bf16_t)(v.y >> 16);
            dst[4 * SW_VS] = (bf16_t)(v.z & 0xffffu); dst[5 * SW_VS] = (bf16_t)(v.z >> 16); dst[6 * SW_VS] = (bf16_t)(v.w & 0xffffu); dst[7 * SW_VS] = (bf16_t)(v.w >> 16); } }
    for (int idx = tid; idx < 64 * 24; idx += NTHREADS) VTs[(idx / 24) * SW_VS + 256 + (idx % 24)] = 0;
    __syncthreads();
    const int i = 16 * w + fr; const size_t qrow = rowb + n * 128 + i;
#pragma unroll 1
    for (int g = 0; g < 4; ++g) {
        const int hq = kvh * 4 + g; const float sink = sinks[hq];
        bf16x8 aq[2];
#pragma unroll
        for (int ks = 0; ks < 2; ++ks) aq[ks] = *(const bf16x8*)(Z + qrow * EV_IN + 2048 + hq * 64 + ks * 32 + 8 * fq);
        f32x4 s[10];
#pragma unroll
        for (int nt = 0; nt < 10; ++nt) { s[nt] = (f32x4){0.f, 0.f, 0.f, 0.f};
#pragma unroll
            for (int ks = 0; ks < 2; ++ks) { const bf16x8 bk = *(const LAS bf16x8*)(Ks + (16 * (w + nt) + fr) * SW_KS + ks * 32 + 8 * fq); s[nt] = MFMA16(bk, aq[ks], s[nt]); } }
        float mx = sink;
#pragma unroll
        for (int nt = 0; nt < 10; ++nt)
#pragma unroll
            for (int c = 0; c < 4; ++c) { const int jj = 16 * (w + nt) + 4 * fq + c; const bool ok = (jj > i) && (jj <= i + 128) && (n > 0 || jj >= 128);
                const float v = ok ? s[nt][c] * 0.125f : -1e30f; s[nt][c] = v; mx = fmaxf(mx, v); }
        mx = fmaxf(mx, __shfl_xor(mx, 16)); mx = fmaxf(mx, __shfl_xor(mx, 32));
        float sum = 0.f;
#pragma unroll
        for (int nt = 0; nt < 10; ++nt) {
#pragma unroll
            for (int c = 0; c < 4; ++c) { const float pv = __expf(s[nt][c] - mx); s[nt][c] = pv; sum += pv; }
            u32x2 wv; wv.x = pk2(s[nt][0], s[nt][1]); wv.y = pk2(s[nt][2], s[nt][3]);
            *(LAS u32x2*)(Pw + fr * SW_PS + 16 * nt + 4 * fq) = wv; }
        sum += __shfl_xor(sum, 16); sum += __shfl_xor(sum, 32);
        sum += __expf(sink - mx);
        LDS_WAIT();
        f32x4 o[4];
#pragma unroll
        for (int nt = 0; nt < 4; ++nt) o[nt] = (f32x4){0.f, 0.f, 0.f, 0.f};
#pragma unroll
        for (int ks = 0; ks < 5; ++ks) { const bf16x8 ap = *(const LAS bf16x8*)(Pw + fr * SW_PS + ks * 32 + 8 * fq);
#pragma unroll
            for (int nt = 0; nt < 4; ++nt) { const bf16x8 bv = *(const LAS bf16x8*)(VTs + (16 * nt + fr) * SW_VS + 16 * w + ks * 32 + 8 * fq); o[nt] = MFMA16(bv, ap, o[nt]); } }
        LDS_WAIT();
        const float inv = 1.f / sum;
#pragma unroll
        for (int nt = 0; nt < 4; ++nt) { u32x2 wv; wv.x = pk2(o[nt][0] * inv, o[nt][1] * inv); wv.y = pk2(o[nt][2] * inv, o[nt][3] * inv);
            *(u32x2*)(MIX + qrow * D + 512 + hq * 64 + 16 * nt + 4 * fq) = wv; }
    }
    __syncthreads();
}

constexpr int LA_S = 136;
constexpr int LA_R0 = 0, LA_R1 = 128 * LA_S * 2, LA_X = 2 * 128 * LA_S * 2;
static_assert(LA_X + 256 * LA_S * 2 <= LDS_BYTES && 128 * 129 * 4 <= 256 * LA_S * 2, "la lds");

template <bool GLA> struct LaC { static constexpr int DV = GLA ? 256 : 128, LD = GLA ? OD_LD : EV_IN, GOFF = GLA ? 2048 : 1536; };

__device__ __forceinline__ void gla_compute_b(LAS unsigned char* lds, int xoff, const bf16_t* Z, size_t row0, int h, const float* Wg, const float* bias, int tid) {
    LAS float* Xb = (LAS float*)(lds + xoff); LAS float* al = (LAS float*)(lds + LA_R0); LAS float* tot = al + 128 * 16;
#ifdef DBG_NOB
    { const int d = tid & 127, jq = tid >> 7; for (int jj = 0; jj < 32; ++jj) { const int j = jq * 32 + jj; Xb[j * 129 + d] = -0.05f * (float)(j + 1) * (1.f + (float)d * (1.f / 128.f)); } __syncthreads(); return; }
#endif
    if (tid < 256) { const int j = tid >> 1, c = tid & 1; const u32x4 v = *(const u32x4*)(Z + (row0 + j) * OD_LD + 3072 + c * 8); float f[8]; unpack8(v, f);
        *(LAS f32x4*)(al + j * 16 + c * 8) = (f32x4){f[0], f[1], f[2], f[3]}; *(LAS f32x4*)(al + j * 16 + c * 8 + 4) = (f32x4){f[4], f[5], f[6], f[7]}; }
    __syncthreads();
    const int d = tid & 127, jq = tid >> 7;
    float wg[16];
#pragma unroll
    for (int r = 0; r < 16; ++r) wg[r] = Wg[r * 512 + h * 128 + d];
    const float bs = bias[h * 128 + d];
    float s = 0.f;
#pragma unroll 4
    for (int jj = 0; jj < 32; ++jj) { const int j = jq * 32 + jj; float x = bs;
#pragma unroll
        for (int r4 = 0; r4 < 4; ++r4) { const f32x4 a = *(const LAS f32x4*)(al + j * 16 + r4 * 4); x += a[0] * wg[r4 * 4 + 0] + a[1] * wg[r4 * 4 + 1] + a[2] * wg[r4 * 4 + 2] + a[3] * wg[r4 * 4 + 3]; }
        const float lg = (fminf(x, 0.f) - __logf(1.f + __expf(-fabsf(x)))) * (1.f / 16.f);
        s += lg; Xb[j * 129 + d] = s; }
    tot[jq * 128 + d] = s;
    __syncthreads();
    float off = 0.f;
#pragma unroll
    for (int q = 0; q < 3; ++q) if (q < jq) off += tot[q * 128 + d];
    if (jq > 0) {
#pragma unroll 4
        for (int jj = 0; jj < 32; ++jj) Xb[(jq * 32 + jj) * 129 + d] += off; }
    __syncthreads();
}

template <bool ROT> __device__ __forceinline__ void load_rot8(const bf16_t* src, const float* cosr, const float* sinr, float (&r1)[8], float (&r2)[8]) {
    const u32x4 a = *(const u32x4*)src, b = *(const u32x4*)(src + 64); unpack8(a, r1); unpack8(b, r2);
    if (ROT) { const f32x4 c0 = *(const f32x4*)cosr, c1 = *(const f32x4*)(cosr + 4), s0 = *(const f32x4*)sinr, s1 = *(const f32x4*)(sinr + 4);
#pragma unroll
        for (int e = 0; e < 8; ++e) { const float cs = e < 4 ? c0[e & 3] : c1[e & 3], sn = e < 4 ? s0[e & 3] : s1[e & 3]; const float t1 = r1[e] * cs - r2[e] * sn, t2 = r1[e] * sn + r2[e] * cs; r1[e] = t1; r2[e] = t2; } }
}

template <bool GLA, int NR> __device__ __forceinline__ void la_stage_vt(LAS unsigned char* lds, int xoff, const bf16_t* Z, size_t row0, int h, int e0, int tid) {
    constexpr int DV = LaC<GLA>::DV, LD = LaC<GLA>::LD;
    LAS bf16_t* VT = (LAS bf16_t*)(lds + xoff);
    const int j = tid & 127, eq = tid >> 7; const bf16_t* vrow = Z + (row0 + j) * LD + 1024 + h * DV + e0 + eq * (NR / 4);
    u32x4 vv[NR / 32];
#pragma unroll
    for (int c = 0; c < NR / 32; ++c) vv[c] = *(const u32x4*)(vrow + c * 8);
#pragma unroll
    for (int c = 0; c < NR / 32; ++c) { const u32x4 v = vv[c]; LAS bf16_t* dst = VT + (eq * (NR / 4) + c * 8) * LA_S + j;
        dst[0 * LA_S] = (bf16_t)(v.x & 0xffffu); dst[1 * LA_S] = (bf16_t)(v.x >> 16); dst[2 * LA_S] = (bf16_t)(v.y & 0xffffu); dst[3 * LA_S] = (bf16_t)(v.y >> 16);
        dst[4 * LA_S] = (bf16_t)(v.z & 0xffffu); dst[5 * LA_S] = (bf16_t)(v.z >> 16); dst[6 * LA_S] = (bf16_t)(v.w & 0xffffu); dst[7 * LA_S] = (bf16_t)(v.w >> 16); }
}

template <bool GLA> __device__ __forceinline__ void la1_unit(LAS unsigned char* lds, const Params& p, int li, int u, int half, int tid, int w, int lane) {
    constexpr int DV = LaC<GLA>::DV, LD = LaC<GLA>::LD, MT = DV / 128;
    const bf16_t* Z = (const bf16_t*)(p.ws + WS_Z); bf16_t* ST = (bf16_t*)(p.ws + WS_ST); float* DEC = (float*)(p.ws + WS_DEC);
    const float* cosT = (const float*)(p.ws + WS_ROT); const float* sinT = cosT + T * 64;
    const int b = u >> 7, h = (u >> 5) & 3, n = u & 31; const size_t row0 = (size_t)b * T + n * 128;
    const int fr = lane & 15, fq = lane >> 4;
    constexpr int LA1X = LA_R1;
    LAS bf16_t* KdT = (LAS bf16_t*)(lds + LA_R0); LAS float* Xb = (LAS float*)(lds + LA1X); LAS bf16_t* VT = (LAS bf16_t*)(lds + LA1X);
    if (GLA) gla_compute_b(lds, LA1X, Z, row0, h, p.od_w_gate_up + (size_t)li * 16 * 512, p.od_gate_bias + li * 512, tid);
    const float lgam = GLA ? 0.f : log1pf(-exp2f(-5.f - (float)h));
    {   const int j = tid & 127, pq = tid >> 7, pos = n * 128 + j; const bf16_t* krow = Z + (row0 + j) * LD + 512 + h * 128;
#pragma unroll
        for (int c = 0; c < 2; ++c) { const int i0 = pq * 16 + c * 8; float r1[8], r2[8];
#ifdef DBG_NOROT
            load_rot8<false>(krow + i0, cosT + pos * 64 + i0, sinT + pos * 64 + i0, r1, r2);
#else
            load_rot8<!GLA>(krow + i0, cosT + pos * 64 + i0, sinT + pos * 64 + i0, r1, r2);
#endif
#pragma unroll
            for (int e = 0; e < 8; ++e) { const int d1 = i0 + e, d2 = d1 + 64; float f1, f2;
                if (GLA) { f1 = __expf(Xb[127 * 129 + d1] - Xb[j * 129 + d1]); f2 = __expf(Xb[127 * 129 + d2] - Xb[j * 129 + d2]); } else { f1 = f2 = __expf(lgam * (float)(127 - j)); }
                KdT[d1 * LA_S + j] = f2bf(r1[e] * f1); KdT[d2 * LA_S + j] = f2bf(r2[e] * f2); } }
#ifndef DBG_NODEC
        if (GLA && w < 2 && half == 0) DEC[(size_t)u * 128 + (tid & 127)] = __expf(Xb[127 * 129 + (tid & 127)]);
#endif
    }
    __syncthreads();
    la_stage_vt<GLA, DV>(lds, LA1X, Z, row0, h, 0, tid);
    __syncthreads();
    f32x4 acc[MT][8];
#pragma unroll
    for (int mt = 0; mt < MT; ++mt)
#pragma unroll
        for (int nt = 0; nt < 8; ++nt) acc[mt][nt] = (f32x4){0.f, 0.f, 0.f, 0.f};
#pragma unroll
    for (int ks = 0; ks < 4; ++ks) { bf16x8 a[MT];
#pragma unroll
        for (int mt = 0; mt < MT; ++mt) a[mt] = *(const LAS bf16x8*)(VT + (w * 16 * MT + 16 * mt + fr) * LA_S + ks * 32 + 8 * fq);
#pragma unroll
        for (int nt = 0; nt < 8; ++nt) { bf16x8 bb = *(const LAS bf16x8*)(KdT + (16 * nt + fr) * LA_S + ks * 32 + 8 * fq);
#ifdef DBG_ONEK
            bb = (bf16x8){0x3f80, 0x3f80, 0x3f80, 0x3f80, 0x3f80, 0x3f80, 0x3f80, 0x3f80};
#endif
#ifdef DBG_ONEV
            a[0] = (bf16x8){0x3f80, 0x3f80, 0x3f80, 0x3f80, 0x3f80, 0x3f80, 0x3f80, 0x3f80};
#endif
#pragma unroll
            for (int mt = 0; mt < MT; ++mt) acc[mt][nt] = MFMA16(bb, a[mt], acc[mt][nt]); } }
    bf16_t* stu = ST + (size_t)u * DV * 128 + (size_t)half * 128 * 128;
#pragma unroll
    for (int mt = 0; mt < MT; ++mt)
#pragma unroll
        for (int nt = 0; nt < 8; ++nt) { u32x2 wv; wv.x = pk2(acc[mt][nt][0], acc[mt][nt][1]); wv.y = pk2(acc[mt][nt][2], acc[mt][nt][3]);
#ifdef DBG_CONSTST
            wv.x = pk2((float)(u & 63), (float)nt); wv.y = pk2((float)fr, (float)fq);
#endif
            *(u32x2*)(stu + (size_t)(w * 16 * MT + 16 * mt + fr) * 128 + 16 * nt + 4 * fq) = wv; }
    __syncthreads();
}

template <bool GLA> __device__ __forceinline__ void la2_phase(const Params& p, int tid, int bx, int rk, int NL) {
    constexpr int DV = LaC<GLA>::DV;
    bf16_t* ST = (bf16_t*)(p.ws + WS_ST); const float* DEC = (const float*)(p.ws + WS_DEC);
    const int totl = 4 * DV * 16;
    for (int itl = rk * NTHREADS + tid; itl < totl; itl += NL * NTHREADS) { const int it = bx * totl + itl;
        const int dg = it & 15, e = (it >> 4) % DV, bh = it / (16 * DV);
        const float cdec = GLA ? 0.f : __expf(128.f * log1pf(-exp2f(-5.f - (float)(bh & 3))));
        float S[8];
#pragma unroll
        for (int k = 0; k < 8; ++k) S[k] = 0.f;
#pragma unroll 8
        for (int n = 0; n < 32; ++n) { const size_t u = (size_t)bh * 32 + n; u32x4* ptr = (u32x4*)(ST + (u * DV + e) * 128 + dg * 8);
            const u32x4 kvw = *ptr; float kv[8]; unpack8(kvw, kv);
            float dc[8];
            if (GLA) { const f32x4 d0 = *(const f32x4*)(DEC + u * 128 + dg * 8), d1 = *(const f32x4*)(DEC + u * 128 + dg * 8 + 4);
                dc[0] = d0[0]; dc[1] = d0[1]; dc[2] = d0[2]; dc[3] = d0[3]; dc[4] = d1[0]; dc[5] = d1[1]; dc[6] = d1[2]; dc[7] = d1[3]; }
            else {
#pragma unroll
                for (int k = 0; k < 8; ++k) dc[k] = cdec; }
            *ptr = pack8(S);
#pragma unroll
            for (int k = 0; k < 8; ++k) S[k] = dc[k] * S[k] + kv[k]; }
    }
}

template <bool GLA> __device__ __forceinline__ void la3_unit(LAS unsigned char* lds, const Params& p, int li, int u, int tid, int w, int lane) {
    constexpr int DV = LaC<GLA>::DV, LD = LaC<GLA>::LD, GOFF = LaC<GLA>::GOFF, NT = DV / 16;
    const bf16_t* Z = (const bf16_t*)(p.ws + WS_Z); const bf16_t* ST = (const bf16_t*)(p.ws + WS_ST); bf16_t* MIX = (bf16_t*)(p.ws + WS_MIX);
    const float* cosT = (const float*)(p.ws + WS_ROT); const float* sinT = cosT + T * 64;
    const float* ng = GLA ? p.od_norm_g + li * 1024 : p.ev_ret_norm_g + li * 512;
    const int b = u >> 7, h = (u >> 5) & 3, n = u & 31; const size_t row0 = (size_t)b * T + n * 128;
    const int fr = lane & 15, fq = lane >> 4;
    LAS bf16_t* Qin = (LAS bf16_t*)(lds + LA_R0); LAS bf16_t* Kin = (LAS bf16_t*)(lds + LA_R1); LAS float* Xb = (LAS float*)(lds + LA_X); LAS bf16_t* Xs = (LAS bf16_t*)(lds + LA_X);
    if (GLA) gla_compute_b(lds, LA_X, Z, row0, h, p.od_w_gate_up + (size_t)li * 16 * 512, p.od_gate_bias + li * 512, tid);
    const float lgam = GLA ? 0.f : log1pf(-exp2f(-5.f - (float)h));
    const float scale = 0.08838834764831845f;
    {   const int j = tid >> 2, pq = tid & 3, pos = n * 128 + j; const bf16_t* qrow = Z + (row0 + j) * LD + h * 128; const bf16_t* krow = qrow + 512;
#pragma unroll
        for (int c = 0; c < 2; ++c) { const int i0 = pq * 8 + c * 32; float q1[8], q2[8], k1[8], k2[8];
            load_rot8<!GLA>(qrow + i0, cosT + pos * 64 + i0, sinT + pos * 64 + i0, q1, q2);
            load_rot8<!GLA>(krow + i0, cosT + pos * 64 + i0, sinT + pos * 64 + i0, k1, k2);
#pragma unroll
            for (int e = 0; e < 8; ++e) { float b1, b2;
                if (GLA) { b1 = Xb[j * 129 + i0 + e]; b2 = Xb[j * 129 + 64 + i0 + e]; } else { b1 = b2 = lgam * (float)(j + 1); }
                q1[e] *= scale * __expf(b1); q2[e] *= scale * __expf(b2); k1[e] *= __expf(-b1); k2[e] *= __expf(-b2); }
            *(LAS u32x4*)(Qin + j * LA_S + i0) = pack8(q1); *(LAS u32x4*)(Qin + j * LA_S + 64 + i0) = pack8(q2);
            *(LAS u32x4*)(Kin + j * LA_S + i0) = pack8(k1); *(LAS u32x4*)(Kin + j * LA_S + 64 + i0) = pack8(k2); }
    }
    __syncthreads();
    {   const bf16_t* stu = ST + (size_t)u * DV * 128;
        u32x4 sv[DV / 32];
#pragma unroll
        for (int i = 0; i < DV / 32; ++i) { const int idx = tid + i * NTHREADS; sv[i] = *(const u32x4*)(stu + (size_t)(idx >> 4) * 128 + (idx & 15) * 8); }
#pragma unroll
        for (int i = 0; i < DV / 32; ++i) { const int idx = tid + i * NTHREADS; *(LAS u32x4*)(Xs + (idx >> 4) * LA_S + (idx & 15) * 8) = sv[i]; } }
    __syncthreads();
    f32x4 acco[NT], accA[8];
#pragma unroll
    for (int nt = 0; nt < NT; ++nt) acco[nt] = (f32x4){0.f, 0.f, 0.f, 0.f};
#pragma unroll
    for (int nt = 0; nt < 8; ++nt) accA[nt] = (f32x4){0.f, 0.f, 0.f, 0.f};
#pragma unroll
    for (int ks = 0; ks < 4; ++ks) { const bf16x8 a = *(const LAS bf16x8*)(Qin + (16 * w + fr) * LA_S + ks * 32 + 8 * fq);
#pragma unroll
        for (int nt = 0; nt < NT; ++nt) { const bf16x8 bb = *(const LAS bf16x8*)(Xs + (16 * nt + fr) * LA_S + ks * 32 + 8 * fq); acco[nt] = MFMA16(bb, a, acco[nt]); }
#pragma unroll
        for (int nt = 0; nt < 8; ++nt) if (nt <= w) { const bf16x8 bb = *(const LAS bf16x8*)(Kin + (16 * nt + fr) * LA_S + ks * 32 + 8 * fq); accA[nt] = MFMA16(bb, a, accA[nt]); } }
    {   const int i = 16 * w + fr;
#pragma unroll
        for (int nt = 0; nt < 8; ++nt)
#pragma unroll
            for (int c = 0; c < 4; ++c) { const int j = 16 * nt + 4 * fq + c; if (j > i) accA[nt][c] = 0.f; } }
    __syncthreads();
#pragma unroll
    for (int nt = 0; nt < 8; ++nt) { u32x2 wv; wv.x = pk2(accA[nt][0], accA[nt][1]); wv.y = pk2(accA[nt][2], accA[nt][3]); *(LAS u32x2*)(Qin + (16 * w + fr) * LA_S + 16 * nt + 4 * fq) = wv; }
    la_stage_vt<GLA, LaC<GLA>::DV>(lds, LA_X, Z, row0, h, 0, tid);
    __syncthreads();
#pragma unroll
    for (int ks = 0; ks < 4; ++ks) if (2 * ks <= w) { const bf16x8 a = *(const LAS bf16x8*)(Qin + (16 * w + fr) * LA_S + ks * 32 + 8 * fq);
#pragma unroll
        for (int nt = 0; nt < NT; ++nt) { const bf16x8 bb = *(const LAS bf16x8*)(Xs + (16 * nt + fr) * LA_S + ks * 32 + 8 * fq); acco[nt] = MFMA16(bb, a, acco[nt]); } }
    float ss = 0.f;
#pragma unroll
    for (int nt = 0; nt < NT; ++nt) ss += (acco[nt][0] * acco[nt][0] + acco[nt][1] * acco[nt][1]) + (acco[nt][2] * acco[nt][2] + acco[nt][3] * acco[nt][3]);
    ss += __shfl_xor(ss, 16); ss += __shfl_xor(ss, 32);
    const float r = rsqrtf(ss * (1.f / DV) + EPS);
    const size_t orow = row0 + 16 * w + fr;
#pragma unroll
    for (int nt = 0; nt < NT; ++nt) { const int e = 16 * nt + 4 * fq; const f32x4 g4 = *(const f32x4*)(ng + h * DV + e);
        const u32x2 gw2 = *(const u32x2*)(Z + orow * LD + GOFF + h * DV + e);
        const float g0 = lo_bf(gw2.x), g1 = hi_bf(gw2.x), g2 = lo_bf(gw2.y), g3 = hi_bf(gw2.y);
        const float v0 = acco[nt][0] * r * g4[0] * (g0 / (1.f + __expf(-g0))), v1 = acco[nt][1] * r * g4[1] * (g1 / (1.f + __expf(-g1)));
        const float v2 = acco[nt][2] * r * g4[2] * (g2 / (1.f + __expf(-g2))), v3 = acco[nt][3] * r * g4[3] * (g3 / (1.f + __expf(-g3)));
        u32x2 wv; wv.x = pk2(v0, v1); wv.y = pk2(v2, v3);
        *(u32x2*)(MIX + orow * D + h * DV + e) = wv; }
    __syncthreads();
}

__device__ __forceinline__ float block_sum(float v, LAS float* red, int tid) {
    v = wave_sum(v); __syncthreads(); if ((tid & 63) == 0) red[tid >> 6] = v; __syncthreads();
    float t = 0.f;
#pragma unroll
    for (int i = 0; i < NWAVES; ++i) t += red[i];
    return t;
}
template <bool ADD> __device__ __forceinline__ void t0_rmsnorm_(const LAS float* in, const float* g, LAS float* dst, LAS float* red, int tid) {
    const float a = in[tid], b = in[tid + 512]; const float r = rsqrtf(block_sum(a * a + b * b, red, tid) * (1.f / D) + EPS);
    if (ADD) { dst[tid] += a * r * g[tid]; dst[tid + 512] += b * r * g[tid + 512]; } else { dst[tid] = a * r * g[tid]; dst[tid + 512] = b * r * g[tid + 512]; }
    __syncthreads();
}
__device__ __forceinline__ void t0_gemv(const float* W, int K, int N, const LAS float* in, LAS float* outv, int act, int tid) {
    for (int n = tid; n < N; n += NTHREADS) { float acc[8];
#pragma unroll
        for (int i = 0; i < 8; ++i) acc[i] = 0.f;
        for (int k = 0; k < K; k += 8) {
#pragma unroll
            for (int i = 0; i < 8; ++i) acc[i] += in[k + i] * W[(size_t)(k + i) * N + n]; }
        float a = ((acc[0] + acc[1]) + (acc[2] + acc[3])) + ((acc[4] + acc[5]) + (acc[6] + acc[7]));
        if (act == 2) { a = fmaxf(a, 0.f); a = a * a; }
        outv[n] = a; }
    __syncthreads();
}
constexpr size_t WS_T0 = WS_CTL + 65536;
constexpr int T0_H = 0, T0_U = 8192, T0_Z = 16384, T0_MIX = 49152, T0_Y = 57344;
__device__ __forceinline__ void t0_skinny(const float* W, int K, int N, const float* in, int ldi, float* outp, int ldo, int act, LAS unsigned char* lds, int tid) {
    const int CW = N >= 2048 ? 16 : 4, NKP = NTHREADS / CW, KS = K / NKP;
    const int c = tid % CW, kp = tid / CW, col = blockIdx.x * CW + c;
    if (blockIdx.x * CW >= N) return;
    float acc[8];
#pragma unroll
    for (int r = 0; r < 8; ++r) acc[r] = 0.f;
    if (col < N) {
        for (int k = kp * KS; k < (kp + 1) * KS; k += 4) { float w[4];
#pragma unroll
            for (int i = 0; i < 4; ++i) w[i] = W[(size_t)(k + i) * N + col];
#pragma unroll
            for (int r = 0; r < 8; ++r) { const f32x4 x = *(const f32x4*)(in + (size_t)r * ldi + k); acc[r] += x[0] * w[0] + x[1] * w[1] + x[2] * w[2] + x[3] * w[3]; } } }
#pragma unroll
    for (int r = 0; r < 8; ++r) { float a = acc[r]; for (int o = CW; o < 64; o <<= 1) a += __shfl_xor(a, o); acc[r] = a; }
    LAS float* part = (LAS float*)lds;
    if ((tid & 63) < CW) {
#pragma unroll
        for (int r = 0; r < 8; ++r) part[((tid >> 6) * CW + c) * 8 + r] = acc[r]; }
    __syncthreads();
    if (tid < CW * 8) { const int cc = tid >> 3, r = tid & 7; float a = 0.f;
#pragma unroll
        for (int q = 0; q < NWAVES; ++q) a += part[(q * CW + cc) * 8 + r];
        if (act == 2) { a = fmaxf(a, 0.f); a = a * a; }
        const int n = blockIdx.x * CW + cc; if (n < N) outp[(size_t)r * ldo + n] = a; }
    __syncthreads();
}
__device__ __forceinline__ void t0_load(LAS float* dst, const float* src, int n, int tid) { for (int i = tid; i < n; i += NTHREADS) dst[i] = src[i]; __syncthreads(); }
__device__ __forceinline__ void t0_store(float* dst, const LAS float* src, int n, int tid) { for (int i = tid; i < n; i += NTHREADS) dst[i] = src[i]; __syncthreads(); }

__device__ __forceinline__ void t0_mix_even(const Params& p, int li, const LAS float* z, LAS float* mix, LAS float* sc, int tid) {
            if (tid < 4 * 64) { const int hh = tid >> 6, l = tid & 63; float a = z[hh * 128 + l] * z[512 + hh * 128 + l] + z[hh * 128 + 64 + l] * z[512 + hh * 128 + 64 + l];
                float v2 = z[1024 + hh * 128 + l] * z[1024 + hh * 128 + l] + z[1024 + hh * 128 + 64 + l] * z[1024 + hh * 128 + 64 + l];
                a = wave_sum(a) * 0.08838834764831845f; v2 = wave_sum(v2); if (l == 0) { sc[2 * hh] = a; sc[2 * hh + 1] = a * a * v2 * (1.f / 128.f); } }
            __syncthreads();
            { const int hh = tid >> 7, e = tid; const float sv = sc[2 * hh], r = rsqrtf(sc[2 * hh + 1] + EPS), gt = z[1536 + e];
              mix[e] = sv * z[1024 + e] * r * p.ev_ret_norm_g[li * 512 + e] * (gt / (1.f + expf(-gt))); }
            { const int hq = tid >> 6, l = tid & 63, kv = hq >> 2; float a = wave_sum(z[2048 + hq * 64 + l] * z[2560 + kv * 64 + l]) * 0.125f;
              const float sink = p.ev_sinks[li * 8 + hq], m = fmaxf(a, sink), pe = expf(a - m), den = pe + expf(sink - m);
              mix[512 + hq * 64 + l] = (pe / den) * z[2688 + kv * 64 + l]; }
            __syncthreads();
}
__device__ __forceinline__ void t0_mix_odd(const Params& p, int li, const LAS float* z, LAS float* mix, LAS float* sc, int tid) {
            if (tid < 4 * 64) { const int hh = tid >> 6, l = tid & 63; float a = z[hh * 128 + l] * z[512 + hh * 128 + l] + z[hh * 128 + 64 + l] * z[512 + hh * 128 + 64 + l];
                float v2 = 0.f;
#pragma unroll
                for (int q = 0; q < 4; ++q) { const float vv = z[1024 + hh * 256 + q * 64 + l]; v2 += vv * vv; }
                a = wave_sum(a) * 0.08838834764831845f; v2 = wave_sum(v2); if (l == 0) { sc[2 * hh] = a; sc[2 * hh + 1] = a * a * v2 * (1.f / 256.f); } }
            __syncthreads();
#pragma unroll
            for (int q = 0; q < 2; ++q) { const int e = tid + 512 * q, hh = e >> 8; const float sv = sc[2 * hh], r = rsqrtf(sc[2 * hh + 1] + EPS), gt = z[2048 + e];
                mix[e] = sv * z[1024 + e] * r * p.od_norm_g[li * 1024 + e] * (gt / (1.f + expf(-gt))); }
            __syncthreads();
}
__device__ __forceinline__ void t0_path(const Params& p, LAS unsigned char* lds, int b, int tid, int nlayers = DEPTH) {
    LAS float* h = (LAS float*)lds; LAS float* u = h + 1024; LAS float* z = u + 1024; LAS float* mix = z + 4096; LAS float* y = mix + 1024; LAS float* red = y + 1024; LAS float* sc = red + 16;
    h[tid] = p.x[(size_t)b * T * D + tid]; h[tid + 512] = p.x[(size_t)b * T * D + tid + 512];
    __syncthreads();
#pragma unroll 1
    for (int layer = 0; layer < nlayers; ++layer) { const int li = layer >> 1; const float* ng = p.norm_g + (size_t)layer * 4 * D;
        t0_rmsnorm_<false>(h, ng, u, red, tid);
        if (!(layer & 1)) {
            t0_gemv(p.ev_w_in + (size_t)li * 1024 * EV_IN, 1024, EV_IN, u, z, 0, tid);
            t0_mix_even(p, li, z, mix, sc, tid);
            t0_gemv(p.ev_w_out + (size_t)li * 1024 * 1024, 1024, 1024, mix, y, 0, tid);
        } else {
            t0_gemv(p.od_w_in + (size_t)li * 1024 * OD_IN, 1024, OD_IN, u, z, 0, tid);
            t0_mix_odd(p, li, z, mix, sc, tid);
            t0_gemv(p.od_w_out + (size_t)li * 1024 * 1024, 1024, 1024, mix, y, 0, tid);
        }
        t0_rmsnorm_<true>(y, ng + D, h, red, tid);
        t0_rmsnorm_<false>(h, ng + 2 * D, u, red, tid);
        t0_gemv(p.w_up + (size_t)layer * 1024 * FF, 1024, FF, u, z, 2, tid);
        t0_gemv(p.w_down + (size_t)layer * FF * 1024, FF, 1024, z, y, 0, tid);
        t0_rmsnorm_<true>(y, ng + 3 * D, h, red, tid);
    }
#ifdef DBG_T0CMP
    { const float d0 = fabsf(p.out[(size_t)b * T * D + tid] - h[tid]), d1 = fabsf(p.out[(size_t)b * T * D + tid + 512] - h[tid + 512]);
      if (d0 > DBG_T0CMP || d1 > DBG_T0CMP) p.out[(size_t)b * T * D + tid] = __builtin_nanf(""); }
#else
    p.out[(size_t)b * T * D + tid] = h[tid]; p.out[(size_t)b * T * D + tid + 512] = h[tid + 512];
#endif
}

struct XcdOrder {
    int nN, nu, NL, bx, rk, blk;
    __device__ void init(int N, int G, int c) { nN = N / pg8::BM; nu = 16 * nN; NL = G >> 3; bx = c & 7; rk = c >> 3; blk = (NL == 32) ? 1 : 0; }
    __device__ bool next(int i, pg8::Unit& u) const {
        if (blk) { if (nN == 13 && i >= 6) { if (i > 6 || rk >= 16) return false; u.pm = bx * 16 + rk; u.pn = 12; return true; }
            const int pn = 4 * (i >> 1) + (rk >> 3); if (pn >= nN) return false; u.pm = bx * 16 + 8 * (i & 1) + (rk & 7); u.pn = pn; return true; }
        const int L = i * NL + rk; if (L >= nu) return false; u.pm = bx * 16 + (L & 15); u.pn = L >> 4; return true; }
    __device__ __forceinline__ void a_ready(const pg8::Unit&) const {}
    __device__ __forceinline__ void done(const pg8::Unit&) const {}
};
#ifndef PG8_ALIGN_OPT
#define PG8_ALIGN_OPT true
#endif
#ifndef PG8_SP2_OPT
#define PG8_SP2_OPT true
#endif
#define GAS __attribute__((address_space(1)))
#define XB_TMO      128
#define XB_XCNT(j)  (256  + 64 * (j))
#define XB_XSUB(j)  (1280 + 64 * (j))
#define XB_XGEN(j)  (2304 + 64 * (j))
#define XB_TOP      3328
#define XB_TOPGEN   3392
#define XCD_BAR_WORDS 3456
#define XB_SPIN_CAP (1u << 18)

__device__ __forceinline__ unsigned xb_ld(unsigned* p)              { return __hip_atomic_load(p, __ATOMIC_RELAXED, __HIP_MEMORY_SCOPE_AGENT); }
__device__ __forceinline__ unsigned xb_add(unsigned* p, unsigned v) { return __hip_atomic_fetch_add(p, v, __ATOMIC_RELAXED, __HIP_MEMORY_SCOPE_AGENT); }
__device__ __forceinline__ unsigned xb_xcc_id() { return (unsigned)__builtin_amdgcn_s_getreg((3 << 11) | 20) & 0xFu; }
#define XB_SPIN(cond, bar) do { unsigned _sp = 0; while (cond) { __builtin_amdgcn_s_sleep(1); \
    if ((++_sp & 255u) == 0u) { if (xb_ld(&(bar)[XB_TMO])) break; if (_sp > XB_SPIN_CAP) { atomicAdd(&(bar)[XB_TMO], 1u); break; } } } } while (0)

struct XcdBarrier {
    unsigned* bar; unsigned x;
    volatile LAS unsigned* st;
};

__device__ __forceinline__ XcdBarrier xcd_barrier_post(unsigned* bar, volatile LAS unsigned* st) {
    XcdBarrier b; b.bar = bar; b.x = xb_xcc_id(); b.st = st;
    if (threadIdx.x == 0) (void)xb_add(&bar[XB_XCNT(b.x)], 1u);
    return b;
}
__device__ __forceinline__ void xcd_barrier_complete(unsigned* bar, unsigned x, unsigned& nloc, unsigned& nx) {
    const unsigned G = gridDim.x * gridDim.y * gridDim.z;
    unsigned sum, cnt, mine, sp = 0u;
    for (;;) {
        sum = 0u; cnt = 0u; mine = 0u;
#pragma unroll
        for (unsigned j = 0; j < 16; ++j) { const unsigned c = xb_ld(&bar[XB_XCNT(j)]); sum += c; cnt += (c > 0u) ? 1u : 0u; mine = (j == x) ? c : mine; }
        if (sum == G) break;
        __builtin_amdgcn_s_sleep(1);
        if ((++sp & 255u) == 0u) { if (xb_ld(&bar[XB_TMO])) break; if (sp > XB_SPIN_CAP) { atomicAdd(&bar[XB_TMO], 1u); break; } }
    }
    nloc = mine > 0u ? mine : 1u; nx = cnt > 0u ? cnt : 1u;
}

__device__ __forceinline__ void xcd_barrier(const XcdBarrier& b) {
    asm volatile("s_waitcnt vmcnt(0)" ::: "memory");
    __syncthreads();
    if (threadIdx.x == 0) {
        unsigned* bar = b.bar;
        __builtin_amdgcn_s_waitcnt(0);
        unsigned nloc = b.st[0], nx = b.st[1];
        if (nloc == 0u) { xcd_barrier_complete(bar, b.x, nloc, nx); b.st[0] = nloc; b.st[1] = nx; }
        const unsigned old = xb_add(&bar[XB_XSUB(b.x)], 1u);
        const unsigned gen = old / nloc;
        if (old + 1u == (gen + 1u) * nloc) {
            __builtin_amdgcn_fence(__ATOMIC_RELEASE, "agent");
            asm volatile("s_waitcnt vmcnt(0)" ::: "memory");
            const unsigned og = xb_add(&bar[XB_TOP], 1u);
            const unsigned tg = og / nx;
            if (og + 1u == (tg + 1u) * nx) xb_add(&bar[XB_TOPGEN], 1u);
            else XB_SPIN(xb_ld(&bar[XB_TOPGEN]) == tg, bar);
            __builtin_amdgcn_fence(__ATOMIC_ACQUIRE, "agent");
            xb_add(&bar[XB_XGEN(b.x)], 1u);
            asm volatile("s_waitcnt vmcnt(0)" ::: "memory");
        } else {
            XB_SPIN(xb_ld(&bar[XB_XGEN(b.x)]) == gen, bar);
            __builtin_amdgcn_fence(__ATOMIC_ACQUIRE, "agent");
            asm volatile("s_waitcnt vmcnt(0)" ::: "memory");
        }
    }
    __syncthreads();
}

#define GRID_SYNC() xcd_barrier(xbar)
__global__ void __launch_bounds__(NTHREADS, 2) mega_fwd(Params p) {
    extern __shared__ __attribute__((aligned(16))) unsigned char lds_raw[];
    LAS unsigned char* lds = (LAS unsigned char*)lds_raw;
    cg::grid_group grid = cg::this_grid();
    const int G = gridDim.x;
#ifdef DBG_DELAY_US
#pragma unroll 1
    for (int dly = 0; dly < DBG_DELAY_US / 3; ++dly) __builtin_amdgcn_s_sleep(127);
#endif
    volatile LAS unsigned* xst = (volatile LAS unsigned*)(lds + LDS_BYTES - 16);
    if (threadIdx.x < 2) xst[threadIdx.x] = 0u;
    __syncthreads();
    const XcdBarrier xbar = xcd_barrier_post((unsigned*)(p.ws + WS_CTL), xst);
    if (p.s_lo == 0) {
        {   int tid = threadIdx.x; asm volatile("" : "+v"(tid)); const int lane = tid & 63, wave = __builtin_amdgcn_readfirstlane(tid >> 6);
            prologue_phase(p, lds, tid, wave, lane);
            if (blockIdx.x < NB) {
                __syncthreads(); float* T0 = (float*)(p.ws + WS_T0); const int b = blockIdx.x;
                LAS float* h = (LAS float*)lds; LAS float* u = h + 1024; LAS float* red = h + 8192;
                t0_load(h, p.x + (size_t)b * T * D, 1024, tid); t0_rmsnorm_<false>(h, p.norm_g, u, red, tid);
                t0_store(T0 + T0_H + b * 1024, h, 1024, tid); t0_store(T0 + T0_U + b * 1024, u, 1024, tid); } }
        if (p.s_hi > 1) {
            asm volatile("s_waitcnt vmcnt(0) lgkmcnt(0)" ::: "memory"); __syncthreads();
            grid.sync();
            GRID_SYNC();
        }
    }

#pragma unroll 1
    for (int layer_i = 0; layer_i < DEPTH; ++layer_i) {
#pragma unroll 1
        for (int ph = 0; ph < 9; ++ph) {
            const int step = 1 + layer_i * 9 + ph; if (step < p.s_lo || step >= p.s_hi) continue;
            int layer = layer_i; asm volatile("" : "+s"(layer));
            const int li = layer >> 1; const bool odd = layer & 1;
            int tid = threadIdx.x; asm volatile("" : "+v"(tid)); const int lane = tid & 63, wave = __builtin_amdgcn_readfirstlane(tid >> 6);
            const int gw = blockIdx.x * NWAVES + wave, NGW = G * NWAVES;
            int wv = tid >> 6; asm volatile("" : "+v"(wv));
            const int bx = blockIdx.x & 7, rk = blockIdx.x >> 3, NL = G >> 3;
            unsigned char* ws = p.ws; asm volatile("" : "+s"(ws));
            bf16_t* U = (bf16_t*)(ws + WS_U); bf16_t* MIX = (bf16_t*)(ws + WS_MIX); bf16_t* Zb = (bf16_t*)(ws + WS_Z);
            {
                float* T0 = (float*)(ws + WS_T0); const float* ngl = p.norm_g + (size_t)layer * 4 * D; const int b = blockIdx.x;
                LAS float* h = (LAS float*)lds; LAS float* u = h + 1024; LAS float* z = u + 1024; LAS float* mix = z + 4096; LAS float* y = mix + 1024; LAS float* red = y + 1024; LAS float* sc = red + 16;
                if (ph == 0) t0_skinny(odd ? p.od_w_in + (size_t)li * 1024 * OD_IN : p.ev_w_in + (size_t)li * 1024 * EV_IN, 1024, odd ? OD_IN : EV_IN, T0 + T0_U, 1024, T0 + T0_Z, 4096, 0, lds, tid);
                else if (ph == 4) t0_skinny((odd ? p.od_w_out : p.ev_w_out) + (size_t)li * 1024 * 1024, 1024, 1024, T0 + T0_MIX, 1024, T0 + T0_Y, 1024, 0, lds, tid);
                else if (ph == 6) t0_skinny(p.w_up + (size_t)layer * 1024 * FF, 1024, FF, T0 + T0_U, 1024, T0 + T0_Z, 4096, 2, lds, tid);
                else if (ph == 7) t0_skinny(p.w_down + (size_t)layer * FF * 1024, FF, 1024, T0 + T0_Z, 4096, T0 + T0_Y, 1024, 0, lds, tid);
                else if (b < NB && ph == 1) { t0_load(z, T0 + T0_Z + b * 4096, 4096, tid); if (odd) t0_mix_odd(p, li, z, mix, sc, tid); else t0_mix_even(p, li, z, mix, sc, tid);
                    t0_store(T0 + T0_MIX + b * 1024, mix, 1024, tid); }
                else { }
            }
            if (ph == 0 || ph == 4 || ph == 6 || ph == 7) {
                pg8::Gemm g; pg8::EpiSt E; E.Of0 = nullptr; E.Of1 = nullptr;
                if (ph == 0) { g.A = layer == 0 ? U : (const bf16_t*)(ws + WS_ST); g.K = 1024; E.O = Zb; E.act = 0;
                    if (!odd) { g.Bt = (const bf16_t*)(ws + WS_EVIN) + (size_t)li * EV_IN * 1024; g.N = EV_IN; E.ldc = EV_IN; E.nvalid = EV_IN; }
                    else { g.Bt = (const bf16_t*)(ws + WS_ODIN) + (size_t)li * OD_INP * 1024; g.N = OD_INP; E.ldc = OD_LD; E.nvalid = OD_IN; } }
                else if (ph == 4) { g.A = MIX; g.K = 1024; g.N = 1024; g.Bt = (const bf16_t*)(ws + (odd ? WS_ODOUT : WS_EVOUT)) + (size_t)li * 1024 * 1024; E.O = U; E.ldc = 1024; E.nvalid = 1024; E.act = 0; E.Of0 = (float*)Zb; }
                else if (ph == 6) { g.A = U; g.K = 1024; g.N = FF; g.Bt = (const bf16_t*)(ws + WS_UP) + (size_t)layer * FF * 1024; E.O = Zb; E.ldc = FF; E.nvalid = FF; E.act = 2; }
                else { g.A = Zb; g.K = FF; g.N = 1024; g.Bt = (const bf16_t*)(ws + WS_DN) + (size_t)layer * 1024 * FF; E.O = U; E.ldc = 1024; E.nvalid = 1024; E.act = 0; E.Of0 = (float*)MIX; }
                g.M = M;
                XcdOrder S; S.init(g.N, G, (int)blockIdx.x);
                pg8::gemm_phase<pg8::EpiSt, XcdOrder, PG8_ALIGN_OPT, PG8_SP2_OPT>(lds, g, S, E);
#ifdef PROBE_DOUBLE_GEMM
                __syncthreads(); pg8::gemm_phase<pg8::EpiSt, XcdOrder, PG8_ALIGN_OPT, PG8_SP2_OPT>(lds, g, S, E);
#endif
            }
#ifndef NO_MIX
            else if (ph == 1) {
#ifdef PROBE_DOUBLE_MIX
              for (int rep = 0; rep < 2; ++rep)
#endif
              {
                if (!odd) { for (int ul = rk; ul < 128 + 64; ul += NL) { if (ul < 128) la1_unit<false>(lds, p, li, bx * 128 + ul, 0, tid, wv, lane);
                                else { const int s = ul - 128; swa_unit(lds, Zb, MIX, p.ev_sinks + li * 8, bx, (s >> 5) & 1, s & 31, tid, wv, lane); } } }
                else { for (int ul = rk; ul < 128; ul += NL) la1_unit<true>(lds, p, li, bx * 128 + ul, 0, tid, wv, lane); }
              }
            } else if (ph == 2) {
                if (!odd) la2_phase<false>(p, tid, bx, rk, NL); else la2_phase<true>(p, tid, bx, rk, NL);
            } else if (ph == 3) {
#ifdef PROBE_DOUBLE_MIX
              for (int rep = 0; rep < 2; ++rep)
#endif
              {
                if (!odd) { for (int ul = rk; ul < 128; ul += NL) la3_unit<false>(lds, p, li, bx * 128 + ul, tid, wv, lane); }
                else { for (int ul = rk; ul < 128; ul += NL) la3_unit<true>(lds, p, li, bx * 128 + ul, tid, wv, lane); }
              }
            }
#endif
            else if (ph == 5) {
                norm_phase((const float*)Zb, nullptr, layer == 0 ? p.x : p.out, p.out, p.norm_g + (layer * 4 + 1) * D, p.norm_g + (layer * 4 + 2) * D, U, gw, NGW, lane, (float*)(ws + WS_T0), false);
            } else {
                norm_phase((const float*)MIX, nullptr, p.out, p.out, p.norm_g + (layer * 4 + 3) * D, layer + 1 < DEPTH ? p.norm_g + ((layer + 1) * 4) * D : nullptr, (bf16_t*)(ws + WS_ST), gw, NGW, lane, (float*)(ws + WS_T0), layer + 1 == DEPTH);
            }
            if (step + 1 < p.s_hi) GRID_SYNC();
#ifdef PROBE_DOUBLE_BAR
            if (step + 1 < p.s_hi) GRID_SYNC();
#endif
        }
    }
    if (p.s_hi > 1 + 9 * DEPTH) {
        if (blockIdx.x < NB) { const float* T0 = (const float*)(p.ws + WS_T0); for (int i = threadIdx.x; i < D; i += NTHREADS) p.out[(size_t)blockIdx.x * T * D + i] = T0[T0_H + blockIdx.x * 1024 + i]; }
    }
}

#ifdef DBG_SEPK
__global__ void __launch_bounds__(NTHREADS, 2) k_mix1_even(Params p, int li) {
    extern __shared__ __attribute__((aligned(16))) unsigned char lds_raw2[];
    LAS unsigned char* lds = (LAS unsigned char*)lds_raw2;
    const int tid = threadIdx.x, lane = tid & 63, wave = __builtin_amdgcn_readfirstlane(tid >> 6);
    const int bx = blockIdx.x & 7, rk = blockIdx.x >> 3, NL = gridDim.x >> 3;
    bf16_t* MIX = (bf16_t*)(p.ws + WS_MIX); bf16_t* Zb = (bf16_t*)(p.ws + WS_Z);
    for (int ul = rk; ul < 128 + 64; ul += NL) { if (ul < 128) la1_unit<false>(lds, p, li, bx * 128 + ul, 0, tid, wv, lane);
        else { const int s = ul - 128; swa_unit(lds, Zb, MIX, p.ev_sinks + li * 8, bx, (s >> 5) & 1, s & 31, tid, wv, lane); } }
}
#endif
#ifdef DBG_T0CHK
__global__ void __launch_bounds__(NTHREADS, 2) k_t0chk(Params p) {
    extern __shared__ __attribute__((aligned(16))) unsigned char lds_raw3[];
    LAS unsigned char* lds = (LAS unsigned char*)lds_raw3; const int tid = threadIdx.x, b = blockIdx.x;
    LAS float* h = (LAS float*)lds; LAS float* u = h + 1024; LAS float* z = u + 1024; LAS float* red = z + 4096 + 2048;
    h[tid] = p.x[(size_t)b * T * D + tid]; h[tid + 512] = p.x[(size_t)b * T * D + tid + 512]; __syncthreads();
    t0_rmsnorm_<false>(h, p.norm_g, u, red, tid);
    t0_gemv(p.ev_w_in, 1024, EV_IN, u, z, 0, tid);
    const bf16_t* Zr = (const bf16_t*)(p.ws + WS_Z) + (size_t)b * T * EV_IN; const bf16_t* Ur = (const bf16_t*)(p.ws + WS_U) + (size_t)b * T * D;
    bool bad = false;
    for (int n = tid; n < EV_IN; n += NTHREADS) { const float zm = __uint_as_float((unsigned)Zr[n] << 16); if (fabsf(zm - z[n]) > 0.05f + 0.02f * fabsf(zm)) bad = true; }
    if (DBG_T0CHK == 3) { bad = false; for (int n = tid; n < D; n += NTHREADS) { const float um = __uint_as_float((unsigned)Ur[n] << 16); if (fabsf(um - u[n]) > 0.02f + 0.01f * fabsf(um)) bad = true; } }
    if (DBG_T0CHK >= 10) { t0_path(p, lds, b, tid, DBG_T0CHK - 10); return; }
    if (DBG_T0CHK == 2) { LAS float* mix = z + 4096; LAS float* sc = red + 16; t0_mix_even(p, 0, z, mix, sc, tid);
        const bf16_t* Mr = (const bf16_t*)(p.ws + WS_MIX) + (size_t)b * T * D; bad = false;
        for (int n = tid; n < D; n += NTHREADS) { const float mm = __uint_as_float((unsigned)Mr[n] << 16); if (fabsf(mm - mix[n]) > 0.05f + 0.05f * fabsf(mm)) bad = true; } }
    if (DBG_T0CHK == 5) { LAS float* mix = z + 4096; LAS float* sc = red + 16; LAS float* y = mix + 1024; t0_mix_even(p, 0, z, mix, sc, tid);
        t0_gemv(p.ev_w_out, 1024, 1024, mix, y, 0, tid); bad = false;
        for (int n = tid; n < D; n += NTHREADS) { const float um = __uint_as_float((unsigned)Ur[n] << 16); if (fabsf(um - y[n]) > 0.03f + 0.05f * fabsf(um)) bad = true; } }
    if (DBG_T0CHK == 6) { LAS float* mix = z + 4096; LAS float* sc = red + 16; LAS float* y = mix + 1024; t0_mix_even(p, 0, z, mix, sc, tid);
        t0_gemv(p.ev_w_out, 1024, 1024, mix, y, 0, tid); t0_rmsnorm_<true>(y, p.norm_g + D, h, red, tid); t0_rmsnorm_<false>(h, p.norm_g + 2 * D, u, red, tid); bad = false;
        for (int n = tid; n < D; n += NTHREADS) { const float hm = p.out[(size_t)b * T * D + n]; if (fabsf(hm - h[n]) > 0.03f + 0.03f * fabsf(hm)) bad = true;
            const float um = __uint_as_float((unsigned)Ur[n] << 16); if (fabsf(um - u[n]) > 0.03f + 0.03f * fabsf(um)) bad = true; } }
    __syncthreads();
    if (bad) p.out[(size_t)(b * T + T - 1) * D + tid] = __builtin_nanf("");
}
#endif
#ifdef DBG_STEPS
__global__ void dbg_dump(Params p) {
    const bf16_t* src = (const bf16_t*)(p.ws + (size_t)DBG_OFF_MIB * MiB);
    for (size_t idx = (size_t)blockIdx.x * blockDim.x + threadIdx.x; idx < (size_t)M * D; idx += (size_t)gridDim.x * blockDim.x) { const size_t m = idx >> 10, c = idx & 1023;
#ifndef DBG_W
#define DBG_W 1024
#endif
        p.out[idx] = c < DBG_W ? __uint_as_float((unsigned)src[m * DBG_LD + DBG_COL + c] << 16) : 0.f; }
}
#endif
extern "C" void kernel_launch(void* const* d_in, const int* in_sizes, int n_in, void* d_out, int out_size, void* d_ws, size_t ws_size, hipStream_t stream) {
    static int grid = 0;
    if (grid == 0) {
        if (n_in != 13 || in_sizes[0] != M * D || out_size != M * D || ws_size < WS_END) { fprintf(stderr, "kernel_launch: unexpected shapes / workspace (n_in %d, ws %zu)\n", n_in, ws_size); grid = -1; return; }
        int dev = 0, cus = 0, per_cu = 0;
        hipGetDevice(&dev); hipDeviceGetAttribute(&cus, hipDeviceAttributeMultiprocessorCount, dev);
        if (hipFuncSetAttribute((const void*)mega_fwd, hipFuncAttributeMaxDynamicSharedMemorySize, LDS_BYTES) != hipSuccess) { fprintf(stderr, "kernel_launch: hipFuncSetAttribute failed\n"); grid = -1; return; }
        if (hipOccupancyMaxActiveBlocksPerMultiprocessor(&per_cu, (const void*)mega_fwd, NTHREADS, LDS_BYTES) != hipSuccess || per_cu < 1) { fprintf(stderr, "kernel_launch: occupancy query gave %d\n", per_cu); per_cu = 1; }
        (void)hipGetLastError();
        grid = cus * per_cu;
    }
    if (grid < 0) return;
    Params p{};
    p.x = (const float*)d_in[0]; p.norm_g = (const float*)d_in[1]; p.w_up = (const float*)d_in[2]; p.w_down = (const float*)d_in[3]; p.ev_w_in = (const float*)d_in[4];
    p.ev_ret_norm_g = (const float*)d_in[5]; p.ev_sinks = (const float*)d_in[6]; p.ev_w_out = (const float*)d_in[7]; p.od_w_in = (const float*)d_in[8]; p.od_w_gate_up = (const float*)d_in[9];
    p.od_gate_bias = (const float*)d_in[10]; p.od_norm_g = (const float*)d_in[11]; p.od_w_out = (const float*)d_in[12];
    p.out = (float*)d_out; p.ws = (unsigned char*)d_ws;
    if (hipMemsetAsync((char*)d_ws + WS_CTL, 0, 16384, stream) != hipSuccess) { fprintf(stderr, "kernel_launch: memset failed\n"); return; }
#ifndef MK_PER_PHASE
#define MK_PER_PHASE 0
#endif
    constexpr int NSTEPS = 1 + 9 * DEPTH;
    if (MK_PER_PHASE) {
#ifdef DBG_STEPS
#ifndef DBG_SKIP_LO
#define DBG_SKIP_LO 0
#define DBG_SKIP_HI 0
#endif
#ifdef DBG_SEPK
        hipFuncSetAttribute((const void*)k_mix1_even, hipFuncAttributeMaxDynamicSharedMemorySize, LDS_BYTES);
#endif
        for (int st = 0; st < DBG_STEPS; ++st) { if (st >= DBG_SKIP_LO && st < DBG_SKIP_HI) continue; p.s_lo = st; p.s_hi = st + 1;
#ifdef DBG_SEPK
            if (st == 2) { hipLaunchKernelGGL(k_mix1_even, dim3(grid), dim3(NTHREADS), LDS_BYTES, stream, p, 0); continue; }
#endif
            hipLaunchKernelGGL(mega_fwd, dim3(grid), dim3(NTHREADS), LDS_BYTES, stream, p); }
#ifndef DBG_NODUMP
        hipLaunchKernelGGL(dbg_dump, dim3(2048), dim3(256), 0, stream, p);
#endif
#ifdef DBG_T0CHK
        hipLaunchKernelGGL(k_t0chk, dim3(8), dim3(NTHREADS), 65536, stream, p);
#endif
#else
        for (int st = 0; st < NSTEPS; ++st) { p.s_lo = st; p.s_hi = st + 1; hipLaunchKernelGGL(mega_fwd, dim3(grid), dim3(NTHREADS), LDS_BYTES, stream, p); }
#endif
    } else {
        p.s_lo = 0; p.s_hi = NSTEPS;
        void* args[] = {&p};
        hipError_t e = hipLaunchCooperativeKernel((const void*)mega_fwd, dim3(grid), dim3(NTHREADS), args, LDS_BYTES, stream);
        if (e != hipSuccess) fprintf(stderr, "kernel_launch: cooperative launch failed: %s (grid %d)\n", hipGetErrorString(e), grid);
    }
}
```
